# Optimizing an MI355X kernel written in HIP

```python
import math
import jax
import jax.numpy as jnp
from jax import lax
import numpy as np

D_MODEL = 2048
BATCH = 2
SEQ = 8192
DEPTH = 2

HEAD_DIM = 128
N_SLOTS = D_MODEL // HEAD_DIM
N_EVEN = (DEPTH + 1) // 2
N_ODD = DEPTH // 2
NSA_HEADS = 8
NSA_GROUPS = 2
NSA_HPG = NSA_HEADS // NSA_GROUPS
CMP_BLOCK = 32
CMP_STRIDE = 16
CMP_HIDDEN = 256
SEL_BLOCK = 64
SEL_TOP_N = 16
WINDOW = 512
MLA_HEADS = 8
MLA_Q_RANK = 512
MLA_KV_RANK = 256
MLA_NOPE = 128
MLA_ROPE = 64
MLA_V = 128
DSA_HEADS = 16
DSA_KV_HEADS = 4
IDX_HEADS = 16
IDX_DIM = 64
IDX_ROPE = 32
DSA_TOPK_MAX = 256
REL_BUCKETS = 32
REL_MAX_DIST = 128
FFN_HIDDEN = 4096
CONV_WIDTH = 3
ROPE_THETA = 10000.0
EPS = 1e-6
Q_BLOCK = 128
NEG = -1e30
FORCE = 1e9

EVEN_COLS = NSA_HEADS * HEAD_DIM + 6 * NSA_GROUPS * HEAD_DIM + 3 * NSA_HEADS + MLA_Q_RANK + MLA_KV_RANK + MLA_ROPE
EVEN_OUT = NSA_HEADS * HEAD_DIM + MLA_HEADS * MLA_V
ODD_COLS = DSA_HEADS * HEAD_DIM + 2 * DSA_KV_HEADS * HEAD_DIM + IDX_HEADS * IDX_DIM + IDX_DIM + IDX_HEADS
ODD_OUT = DSA_HEADS * HEAD_DIM

kernel_name = "hybrid_nsa_mla_dsa_convffn"


def _offsets(sizes):
    return [int(v) for v in np.cumsum(sizes)[:-1]]


def rms_norm(x, g):
    xf = x.astype(jnp.float32)
    y = xf * lax.rsqrt(jnp.mean(xf * xf, axis=-1, keepdims=True) + EPS)
    return (y * g.astype(jnp.float32)).astype(x.dtype)


def masked_softmax(logits, mask):
    lf = jnp.where(mask, logits.astype(jnp.float32), NEG)
    p = jax.nn.softmax(lf, axis=-1)
    return p * jnp.any(mask, axis=-1, keepdims=True)


def t5_bucket(dist):
    n = jnp.maximum(dist, 0)
    max_exact = REL_BUCKETS // 2
    nf = jnp.maximum(n, 1).astype(jnp.float32)
    large = max_exact + (jnp.log(nf / max_exact) / math.log(REL_MAX_DIST / max_exact)
                         * (REL_BUCKETS - max_exact)).astype(jnp.int32)
    large = jnp.minimum(large, REL_BUCKETS - 1)
    return jnp.where(n < max_exact, n, large)


def rope_tables(seq_len, dim):
    half = dim // 2
    inv = ROPE_THETA ** (-jnp.arange(half, dtype=jnp.float32) / half)
    ang = jnp.arange(seq_len, dtype=jnp.float32)[:, None] * inv[None, :]
    return jnp.cos(ang), jnp.sin(ang)


def apply_rope(x, cos, sin):
    half = x.shape[-1] // 2
    x1 = x[..., :half].astype(jnp.float32)
    x2 = x[..., half:].astype(jnp.float32)
    return jnp.concatenate([x1 * cos - x2 * sin, x1 * sin + x2 * cos], axis=-1).astype(x.dtype)


def ada_modulate(c, w, b):
    m = jax.nn.silu(c) @ w + b
    shift, scale, gate = jnp.split(m, 3, axis=-1)
    return shift[:, None], scale[:, None], gate[:, None]


def compress(x, pe, w1, b1, w2, b2):
    B_, S_, G_, d = x.shape
    ch = x.reshape(B_, S_ // CMP_STRIDE, CMP_STRIDE, G_, d)
    blk = jnp.concatenate([ch[:, :-1], ch[:, 1:]], axis=2) + pe[None, None, :, None, :]
    nc = blk.shape[1]
    flat = jnp.moveaxis(blk, 3, 2).reshape(B_, nc, G_, CMP_BLOCK * d)
    return jax.nn.gelu(flat @ w1 + b1) @ w2 + b2


def nsa_attention(q, k_cmp, v_cmp, k_slc, v_slc, k_win, v_win, gates, tbl):
    B_, S_, H_, d = q.shape
    G_, hpg = NSA_GROUPS, NSA_HPG
    nc = k_cmp.shape[1]
    ns = S_ // SEL_BLOCK
    n_sel = min(SEL_TOP_N, ns)
    nk_sel = n_sel * SEL_BLOCK
    scale = d ** -0.5
    cmp_start = jnp.arange(nc) * CMP_STRIDE
    cmp_end = cmp_start + CMP_BLOCK - 1
    blk_ids = jnp.arange(ns)
    sel_start = blk_ids * SEL_BLOCK
    overlap = jnp.clip(jnp.minimum(cmp_start[:, None] + CMP_BLOCK, sel_start[None, :] + SEL_BLOCK)
                       - jnp.maximum(cmp_start[:, None], sel_start[None, :]), 0, None
                       ).astype(jnp.float32) / CMP_BLOCK
    ks_blocks = k_slc.reshape(B_, ns, SEL_BLOCK, G_, d).transpose(0, 3, 1, 2, 4)
    vs_blocks = v_slc.reshape(B_, ns, SEL_BLOCK, G_, d).transpose(0, 3, 1, 2, 4)
    kw_pad = jnp.pad(k_win, ((0, 0), (WINDOW, 0), (0, 0), (0, 0)))
    vw_pad = jnp.pad(v_win, ((0, 0), (WINDOW, 0), (0, 0), (0, 0)))
    tbl_heads = tbl.reshape(REL_BUCKETS, G_, hpg)
    tbl_g = tbl_heads.transpose(1, 0, 2)
    b_ix = jnp.arange(B_)[:, None, None, None]
    g_ix = jnp.arange(G_)[None, :, None, None]
    off_blk = jnp.arange(SEL_BLOCK)
    off_win = jnp.arange(Q_BLOCK + WINDOW)

    def block(bi):
        q0 = bi * Q_BLOCK
        t = q0 + jnp.arange(Q_BLOCK)
        qb = lax.dynamic_slice_in_dim(q, q0, Q_BLOCK, axis=1).reshape(B_, Q_BLOCK, G_, hpg, d)
        gb = jax.nn.sigmoid(lax.dynamic_slice_in_dim(gates, q0, Q_BLOCK, axis=1).astype(jnp.float32)
                            ).reshape(B_, Q_BLOCK, G_, hpg, 3)
        dist_c = t[:, None] - cmp_end[None, :]
        bias_c = tbl_heads[t5_bucket(dist_c)].transpose(2, 3, 0, 1)
        s_c = jnp.einsum('bqghd,bkgd->bghqk', qb, k_cmp) * scale + bias_c
        p_c = masked_softmax(s_c, dist_c >= 0)
        o_c = jnp.einsum('bghqk,bkgd->bqghd', p_c.astype(v_cmp.dtype), v_cmp)
        imp = jnp.einsum('bghqk,kn->bgqn', p_c, overlap)
        tb = t // SEL_BLOCK
        forced = (blk_ids[None, :] == 0) | (blk_ids[None, :] == tb[:, None]) | (blk_ids[None, :] == tb[:, None] - 1)
        causal_blk = sel_start[None, :] <= t[:, None]
        score = jnp.where(forced, FORCE, jnp.where(causal_blk, imp, NEG))
        _, idx = lax.top_k(score, n_sel)
        k_g = ks_blocks[b_ix, g_ix, idx].reshape(B_, G_, Q_BLOCK, nk_sel, d)
        v_g = vs_blocks[b_ix, g_ix, idx].reshape(B_, G_, Q_BLOCK, nk_sel, d)
        pos_s = (idx[..., None] * SEL_BLOCK + off_blk).reshape(B_, G_, Q_BLOCK, nk_sel)
        dist_s = t[None, None, :, None] - pos_s
        bias_s = jnp.moveaxis(tbl_g[g_ix, t5_bucket(dist_s)], -1, 2)
        s_s = jnp.einsum('bqghd,bgqkd->bghqk', qb, k_g) * scale + bias_s
        p_s = masked_softmax(s_s, (dist_s >= 0)[:, :, None])
        o_s = jnp.einsum('bghqk,bgqkd->bqghd', p_s.astype(v_g.dtype), v_g)
        kw = lax.dynamic_slice_in_dim(kw_pad, q0, Q_BLOCK + WINDOW, axis=1)
        vw = lax.dynamic_slice_in_dim(vw_pad, q0, Q_BLOCK + WINDOW, axis=1)
        pos_w = q0 - WINDOW + off_win
        dist_w = t[:, None] - pos_w[None, :]
        mask_w = (pos_w[None, :] >= 0) & (dist_w >= 0) & (dist_w < WINDOW)
        bias_w = tbl_heads[t5_bucket(dist_w)].transpose(2, 3, 0, 1)
        s_w = jnp.einsum('bqghd,bkgd->bghqk', qb, kw) * scale + bias_w
        p_w = masked_softmax(s_w, mask_w)
        o_w = jnp.einsum('bghqk,bkgd->bqghd', p_w.astype(vw.dtype), vw)
        o = gb[..., 0:1] * o_c + gb[..., 1:2] * o_s + gb[..., 2:3] * o_w
        return o.reshape(B_, Q_BLOCK, H_ * d).astype(q.dtype)

    out = lax.map(block, jnp.arange(S_ // Q_BLOCK))
    return out.transpose(1, 0, 2, 3).reshape(B_, S_, H_ * d)


def mla_attention(q_nope, q_pe, k_nope, k_pe, v):
    B_, S_, H_, _ = q_nope.shape
    dv = v.shape[-1]
    scale = (MLA_NOPE + MLA_ROPE) ** -0.5
    kpos = jnp.arange(S_)

    def block(bi):
        q0 = bi * Q_BLOCK
        t = q0 + jnp.arange(Q_BLOCK)
        qn = lax.dynamic_slice_in_dim(q_nope, q0, Q_BLOCK, axis=1)
        qr = lax.dynamic_slice_in_dim(q_pe, q0, Q_BLOCK, axis=1)
        s = (jnp.einsum('bqhd,bkhd->bhqk', qn, k_nope) + jnp.einsum('bqhd,bkd->bhqk', qr, k_pe)) * scale
        p = masked_softmax(s, kpos[None, :] <= t[:, None])
        o = jnp.einsum('bhqk,bkhd->bqhd', p.astype(v.dtype), v)
        return o.reshape(B_, Q_BLOCK, H_ * dv)

    out = lax.map(block, jnp.arange(S_ // Q_BLOCK))
    return out.transpose(1, 0, 2, 3).reshape(B_, S_, H_ * dv)


def dsa_attention(q, k, v, iq, ik, iw, tbl):
    B_, S_, H_, d = q.shape
    kvh = k.shape[2]
    hpg = H_ // kvh
    k_sel = min(DSA_TOPK_MAX, S_ // 4)
    scale = d ** -0.5
    kpos = jnp.arange(S_)
    b_ix = jnp.arange(B_)[:, None, None]

    def block(bi):
        q0 = bi * Q_BLOCK
        t = q0 + jnp.arange(Q_BLOCK)
        iqb = lax.dynamic_slice_in_dim(iq, q0, Q_BLOCK, axis=1)
        iwb = lax.dynamic_slice_in_dim(iw, q0, Q_BLOCK, axis=1).astype(jnp.float32)
        rel = jax.nn.relu(jnp.einsum('bqhd,bkd->bqhk', iqb, ik).astype(jnp.float32))
        score = jnp.einsum('bqhk,bqh->bqk', rel, iwb)
        score = jnp.where(kpos[None, None, :] <= t[None, :, None], score, NEG)
        _, idx = lax.top_k(score, k_sel)
        kg = k[b_ix, idx]
        vg = v[b_ix, idx]
        dist = t[None, :, None] - idx
        bias = tbl[t5_bucket(dist)].reshape(B_, Q_BLOCK, k_sel, kvh, hpg).transpose(0, 3, 4, 1, 2)
        qb = lax.dynamic_slice_in_dim(q, q0, Q_BLOCK, axis=1).reshape(B_, Q_BLOCK, kvh, hpg, d)
        s = jnp.einsum('bqghd,bqkgd->bghqk', qb, kg) * scale + bias
        p = masked_softmax(s, (dist >= 0)[:, None, None])
        o = jnp.einsum('bghqk,bqkgd->bqghd', p.astype(vg.dtype), vg)
        return o.reshape(B_, Q_BLOCK, H_ * d)

    out = lax.map(block, jnp.arange(S_ // Q_BLOCK))
    return out.transpose(1, 0, 2, 3).reshape(B_, S_, H_ * d)


def even_mixer(h, rel_bias, w_in, w_out, nsa_qk_g, cmp_pe, cmp_w1, cmp_b1, cmp_w2, cmp_b2,
               mla_q_norm_g, mla_kv_norm_g, mla_w_uq, mla_w_ukv, mla_nope_g, mla_rope_g):
    B_, S_, _ = h.shape
    proj = h @ w_in
    sizes = (NSA_HEADS * HEAD_DIM, 6 * NSA_GROUPS * HEAD_DIM, 3 * NSA_HEADS, MLA_Q_RANK, MLA_KV_RANK, MLA_ROPE)
    q_n, kv_n, gate_n, cq, ckv, kpe = jnp.split(proj, _offsets(sizes), axis=-1)
    q_n = rms_norm(q_n.reshape(B_, S_, NSA_HEADS, HEAD_DIM), nsa_qk_g[0])
    kv_n = kv_n.reshape(B_, S_, 6, NSA_GROUPS, HEAD_DIM)
    k_cmp = rms_norm(compress(kv_n[:, :, 0], cmp_pe[0], cmp_w1[0], cmp_b1[0], cmp_w2[0], cmp_b2[0]), nsa_qk_g[1])
    v_cmp = compress(kv_n[:, :, 1], cmp_pe[1], cmp_w1[1], cmp_b1[1], cmp_w2[1], cmp_b2[1])
    k_slc = rms_norm(kv_n[:, :, 2], nsa_qk_g[1])
    k_win = rms_norm(kv_n[:, :, 4], nsa_qk_g[1])
    gates = gate_n.reshape(B_, S_, NSA_HEADS, 3)
    o_nsa = nsa_attention(q_n, k_cmp, v_cmp, k_slc, kv_n[:, :, 3], k_win, kv_n[:, :, 5], gates,
                          rel_bias[:, :NSA_HEADS])
    qf = (rms_norm(cq, mla_q_norm_g) @ mla_w_uq).reshape(B_, S_, MLA_HEADS, MLA_NOPE + MLA_ROPE)
    kvf = (rms_norm(ckv, mla_kv_norm_g) @ mla_w_ukv).reshape(B_, S_, MLA_HEADS, MLA_NOPE + MLA_V)
    cos, sin = rope_tables(S_, MLA_ROPE)
    q_nope = rms_norm(qf[..., :MLA_NOPE], mla_nope_g[0])
    q_pe = apply_rope(rms_norm(qf[..., MLA_NOPE:], mla_rope_g[0]), cos[:, None], sin[:, None])
    k_nope = rms_norm(kvf[..., :MLA_NOPE], mla_nope_g[1])
    k_pe = apply_rope(rms_norm(kpe, mla_rope_g[1]), cos, sin)
    o_mla = mla_attention(q_nope, q_pe, k_nope, k_pe, kvf[..., MLA_NOPE:])
    return jnp.concatenate([o_nsa, o_mla], axis=-1) @ w_out


def odd_mixer(h, rel_bias, w_in, w_out, qk_g):
    B_, S_, _ = h.shape
    proj = h @ w_in
    sizes = (DSA_HEADS * HEAD_DIM, DSA_KV_HEADS * HEAD_DIM, DSA_KV_HEADS * HEAD_DIM, IDX_HEADS * IDX_DIM, IDX_DIM, IDX_HEADS)
    q, k, v, iq, ik, iw = jnp.split(proj, _offsets(sizes), axis=-1)
    q = rms_norm(q.reshape(B_, S_, DSA_HEADS, HEAD_DIM), qk_g[0])
    k = rms_norm(k.reshape(B_, S_, DSA_KV_HEADS, HEAD_DIM), qk_g[1])
    v = v.reshape(B_, S_, DSA_KV_HEADS, HEAD_DIM)
    cos, sin = rope_tables(S_, IDX_ROPE)
    iq = iq.reshape(B_, S_, IDX_HEADS, IDX_DIM)
    iq = jnp.concatenate([apply_rope(iq[..., :IDX_ROPE], cos[:, None], sin[:, None]), iq[..., IDX_ROPE:]], axis=-1) * (IDX_DIM ** -0.5)
    ik = jnp.concatenate([apply_rope(ik[..., :IDX_ROPE], cos, sin), ik[..., IDX_ROPE:]], axis=-1)
    iw = iw * (IDX_HEADS ** -0.5)
    return dsa_attention(q, k, v, iq, ik, iw, rel_bias) @ w_out


def conv_ffn(h, w_up, conv_w, conv_b, w_down):
    S_ = h.shape[1]
    u = h @ w_up
    up = jnp.pad(u, ((0, 0), (CONV_WIDTH - 1, 0), (0, 0)))
    u = sum(conv_w[j] * up[:, j:j + S_] for j in range(CONV_WIDTH)) + conv_b
    gate, val = jnp.split(u, 2, axis=-1)
    return (jax.nn.silu(gate) * val) @ w_down


def setup_inputs(seed: int = 0) -> dict:
    key = jax.random.key(seed)
    ks = jax.random.split(key, 32)

    def w(k, shape, fan_in, mult=1.0):
        return jax.random.normal(k, shape, jnp.float32) * (mult * fan_in ** -0.5)

    def gain(k, shape):
        return 1.0 + 0.05 * jax.random.normal(k, shape, jnp.float32)

    def bias(k, shape, s=0.02):
        return s * jax.random.normal(k, shape, jnp.float32)

    D = D_MODEL
    return {
        "x": jax.random.normal(ks[0], (BATCH, SEQ, D), jnp.float32),
        "c": jax.random.normal(ks[1], (BATCH, D), jnp.float32),
        "rel_bias": bias(ks[2], (REL_BUCKETS, N_SLOTS), 0.5),
        "ada_w": w(ks[3], (DEPTH, 2, D, 3 * D), D, 0.5),
        "ada_b": bias(ks[4], (DEPTH, 2, 3 * D)),
        "norm_g": gain(ks[5], (DEPTH, 2, D)),
        "ev_w_in": w(ks[6], (N_EVEN, D, EVEN_COLS), D),
        "ev_w_out": w(ks[7], (N_EVEN, EVEN_OUT, D), EVEN_OUT),
        "nsa_qk_g": gain(ks[8], (N_EVEN, 2, HEAD_DIM)),
        "cmp_pe": bias(ks[9], (N_EVEN, 2, CMP_BLOCK, HEAD_DIM), 0.1),
        "cmp_w1": w(ks[10], (N_EVEN, 2, CMP_BLOCK * HEAD_DIM, CMP_HIDDEN), CMP_BLOCK * HEAD_DIM),
        "cmp_b1": bias(ks[11], (N_EVEN, 2, CMP_HIDDEN)),
        "cmp_w2": w(ks[12], (N_EVEN, 2, CMP_HIDDEN, HEAD_DIM), CMP_HIDDEN),
        "cmp_b2": bias(ks[13], (N_EVEN, 2, HEAD_DIM)),
        "mla_q_norm_g": gain(ks[14], (N_EVEN, MLA_Q_RANK)),
        "mla_kv_norm_g": gain(ks[15], (N_EVEN, MLA_KV_RANK)),
        "mla_w_uq": w(ks[16], (N_EVEN, MLA_Q_RANK, MLA_HEADS * (MLA_NOPE + MLA_ROPE)), MLA_Q_RANK),
        "mla_w_ukv": w(ks[17], (N_EVEN, MLA_KV_RANK, MLA_HEADS * (MLA_NOPE + MLA_V)), MLA_KV_RANK),
        "mla_nope_g": gain(ks[18], (N_EVEN, 2, MLA_NOPE)),
        "mla_rope_g": gain(ks[19], (N_EVEN, 2, MLA_ROPE)),
        "od_w_in": w(ks[20], (N_ODD, D, ODD_COLS), D),
        "od_w_out": w(ks[21], (N_ODD, ODD_OUT, D), ODD_OUT),
        "dsa_qk_g": gain(ks[22], (N_ODD, 2, HEAD_DIM)),
        "ffn_w_up": w(ks[23], (DEPTH, D, 2 * FFN_HIDDEN), D),
        "ffn_conv_w": w(ks[24], (DEPTH, CONV_WIDTH, 2 * FFN_HIDDEN), CONV_WIDTH),
        "ffn_conv_b": bias(ks[25], (DEPTH, 2 * FFN_HIDDEN)),
        "ffn_w_down": w(ks[26], (DEPTH, FFN_HIDDEN, D), FFN_HIDDEN),
    }


def reference(x, c, rel_bias, ada_w, ada_b, norm_g, ev_w_in, ev_w_out, nsa_qk_g, cmp_pe, cmp_w1, cmp_b1,
              cmp_w2, cmp_b2, mla_q_norm_g, mla_kv_norm_g, mla_w_uq, mla_w_ukv, mla_nope_g, mla_rope_g,
              od_w_in, od_w_out, dsa_qk_g, ffn_w_up, ffn_conv_w, ffn_conv_b, ffn_w_down):
    for i in range(DEPTH):
        j = i // 2
        shift, scale, gate = ada_modulate(c, ada_w[i, 0], ada_b[i, 0])
        h = rms_norm(x, norm_g[i, 0]) * (1.0 + scale) + shift
        if i % 2 == 0:
            mix = even_mixer(h, rel_bias, ev_w_in[j], ev_w_out[j], nsa_qk_g[j], cmp_pe[j], cmp_w1[j],
                             cmp_b1[j], cmp_w2[j], cmp_b2[j], mla_q_norm_g[j], mla_kv_norm_g[j],
                             mla_w_uq[j], mla_w_ukv[j], mla_nope_g[j], mla_rope_g[j])
        else:
            mix = odd_mixer(h, rel_bias, od_w_in[j], od_w_out[j], dsa_qk_g[j])
        x = x + gate * mix
        shift, scale, gate = ada_modulate(c, ada_w[i, 1], ada_b[i, 1])
        h = rms_norm(x, norm_g[i, 1]) * (1.0 + scale) + shift
        x = x + gate * conv_ffn(h, ffn_w_up[i], ffn_conv_w[i], ffn_conv_b[i], ffn_w_down[i])
    return x
```

```cpp
#include <hip/hip_runtime.h>
#include <hip/hip_cooperative_groups.h>
#include <stdint.h>
#include <stdio.h>
namespace cg = cooperative_groups;

typedef unsigned short bf16_t;
typedef unsigned long long u64;
typedef __attribute__((ext_vector_type(8))) short bf16x8;
typedef __attribute__((ext_vector_type(8))) _Float16 f16x8;
typedef __attribute__((ext_vector_type(16))) float f32x16;
typedef __attribute__((ext_vector_type(4))) unsigned u32x4;
typedef __attribute__((ext_vector_type(2))) unsigned u32x2;
typedef __attribute__((ext_vector_type(4))) float f32x4;
typedef __attribute__((ext_vector_type(4))) short s16x4;

#define SEQ 8192
#define NTOK 16384
#define DM 2048
#define EPSF 1e-6f
#define NEG_INF (-__builtin_inff())

constexpr size_t AL(size_t x) { return (x + 255) & ~size_t(255); }
constexpr size_t O_WEVIN  = 0;
constexpr size_t O_WEVOUT = O_WEVIN  + AL(3456ull * 2048 * 2);
constexpr size_t O_WCW1   = O_WEVOUT + AL(2048ull * 2048 * 2);
constexpr size_t O_WCW2   = O_WCW1   + AL(2ull * 256 * 4096 * 2);
constexpr size_t O_WUQ    = O_WCW2   + AL(2ull * 128 * 256 * 2);
constexpr size_t O_WUKV   = O_WUQ    + AL(1536ull * 512 * 2);
constexpr size_t O_WODIN  = O_WUKV   + AL(2048ull * 256 * 2);
constexpr size_t O_WODOUT = O_WODIN  + AL(4224ull * 2048 * 2);
constexpr size_t O_WUP    = O_WODOUT + AL(2048ull * 2048 * 2);
constexpr size_t O_WDOWN  = O_WUP    + AL(2ull * 8192 * 2048 * 2);
constexpr size_t O_ADAP   = O_WDOWN  + AL(2ull * 2048 * 4096 * 2);
constexpr size_t O_ADAM   = O_ADAP   + AL(4ull * 32 * 2 * 6144 * 4);
constexpr size_t O_CB1PART= O_ADAM   + AL(4ull * 2 * 6144 * 4);
constexpr size_t O_CB1P   = O_CB1PART+ AL(2ull * 16 * 256 * 4);
constexpr size_t O_ROPE64 = O_CB1P   + AL(2ull * 256 * 4);
constexpr size_t O_ROPE32 = O_ROPE64 + AL(2ull * 8192 * 32 * 4);
constexpr size_t O_H      = O_ROPE32 + AL(2ull * 8192 * 16 * 4);
constexpr size_t O_REG    = O_H      + AL(16384ull * 2048 * 2);
constexpr size_t O_QN     = O_REG;
constexpr size_t O_KSLC   = O_QN     + AL(16384ull * 1024 * 2);
constexpr size_t O_KWIN   = O_KSLC   + AL(16384ull * 256 * 2);
constexpr size_t O_VSLCT  = O_KWIN   + AL(16384ull * 256 * 2);
constexpr size_t O_VWINT  = O_VSLCT  + AL(16384ull * 256 * 2);
constexpr size_t O_KVSRC  = O_VWINT  + AL(16384ull * 256 * 2);
constexpr size_t O_HID    = O_KVSRC  + AL(8ull * 8192 * 128 * 2 + 65536);
constexpr size_t O_KCMP   = O_HID    + AL(8ull * 512 * 256 * 2);
constexpr size_t O_VCMPT  = O_KCMP   + AL(4ull * 512 * 128 * 2);
constexpr size_t O_CQ     = O_VCMPT  + AL(4ull * 512 * 128 * 2);
constexpr size_t O_CKV    = O_CQ     + AL(16384ull * 512 * 2);
constexpr size_t O_SSQ    = O_CKV    + AL(16384ull * 256 * 2);
constexpr size_t O_GATES  = O_SSQ    + AL(16384ull * 8 * 4);
constexpr size_t O_QMLA   = O_GATES  + AL(16384ull * 24 * 4);
constexpr size_t O_KMLA   = O_QMLA   + AL(16384ull * 8 * 192 * 2);
constexpr size_t O_VMLAT  = O_KMLA   + AL(16384ull * 8 * 192 * 2);
constexpr size_t O_OC     = O_VMLAT  + AL(16384ull * 1024 * 2);
constexpr size_t O_SELM   = O_OC     + AL(16384ull * 1024 * 4);
constexpr size_t O_ATT0   = O_SELM   + AL(4ull * 8192 * 16);
constexpr size_t O_L0END  = O_ATT0   + AL(16384ull * 2048 * 2);
constexpr size_t O_QD     = O_REG;
constexpr size_t O_KD     = O_QD     + AL(16384ull * 2048 * 2);
constexpr size_t O_VDT    = O_KD     + AL(16384ull * 512 * 2);
constexpr size_t O_IQ     = O_VDT    + AL(16384ull * 512 * 2);
constexpr size_t O_IK     = O_IQ     + AL(16384ull * 1024 * 2);
constexpr size_t O_IW     = O_IK     + AL(16384ull * 64 * 2 + 65536);
constexpr size_t O_BITM   = O_IW     + AL(16384ull * 16 * 4);
constexpr size_t O_SC     = O_BITM   + AL(16384ull * 128 * 8);
constexpr size_t SC_PERB  = 1024ull * (256ull * 257 / 2);
constexpr size_t O_ATT1   = O_SC;
constexpr size_t O_L1END  = O_SC     + AL(2ull * SC_PERB * 4);
constexpr size_t O_ACT    = O_REG;
constexpr size_t O_ACTEND = O_ACT    + AL(16384ull * 4096 * 2);
constexpr size_t cmax(size_t a, size_t b) { return a > b ? a : b; }
constexpr size_t O_BAR    = cmax(cmax(O_L0END, O_L1END), O_ACTEND);
constexpr size_t WS_NEED  = O_BAR + 16384;

struct Params {
  const float* in[27];
  float* out;
  unsigned char* ws;
  int ph_lo, ph_hi;
};
enum { I_X = 0, I_C, I_REL, I_ADAW, I_ADAB, I_NORMG, I_EVIN, I_EVOUT, I_NSAG, I_CPE, I_CW1, I_CB1, I_CW2, I_CB2,
       I_MQG, I_MKVG, I_WUQ, I_WUKV, I_NOPEG, I_ROPEG, I_ODIN, I_ODOUT, I_DSAG, I_FUP, I_FCW, I_FCB, I_FDOWN };

#define SMEM_BYTES 68608

__device__ __forceinline__ int tidx_() { int t = threadIdx.x; asm volatile("" : "+v"(t)); return t; }
#define TIDX tidx_()
#define SNAKE_LOOP(it, n) for (int _r = 0, it = blockIdx.x; _r * (int)gridDim.x < (n); ++_r, it = _r * gridDim.x + ((_r & 1) ? (gridDim.x - 1 - blockIdx.x) : blockIdx.x)) if (it < (n))
__device__ __forceinline__ unsigned short f2bf(float f) {
  unsigned u = __float_as_uint(f);
  u += 0x7fffu + ((u >> 16) & 1u);
  return (unsigned short)(u >> 16);
}
typedef __attribute__((ext_vector_type(2))) float f32x2_t;
typedef __attribute__((ext_vector_type(2))) __bf16 bf16x2_t;
__device__ __forceinline__ unsigned pack2(float a, float b) {
  f32x2_t v = {a, b};
  bf16x2_t r = __builtin_convertvector(v, bf16x2_t);
  return __builtin_bit_cast(unsigned, r);
}
#define EXP2F(x) __builtin_amdgcn_exp2f(x)
__device__ __forceinline__ float xmax32(float v) {
  auto r = __builtin_amdgcn_permlane32_swap(__float_as_uint(v), __float_as_uint(v), false, false);
  return fmaxf(__uint_as_float(r[0]), __uint_as_float(r[1]));
}
__device__ __forceinline__ float xsum32(float v) {
  auto r = __builtin_amdgcn_permlane32_swap(__float_as_uint(v), __float_as_uint(v), false, false);
  return __uint_as_float(r[0]) + __uint_as_float(r[1]);
}
#define LOG2E 1.4426950408889634f
__device__ __forceinline__ float dpp_row_sum(float v) {
  v += __uint_as_float(__builtin_amdgcn_update_dpp(0u, __float_as_uint(v), 0xB1, 0xF, 0xF, true));
  v += __uint_as_float(__builtin_amdgcn_update_dpp(0u, __float_as_uint(v), 0x4E, 0xF, 0xF, true));
  v += __uint_as_float(__builtin_amdgcn_update_dpp(0u, __float_as_uint(v), 0x141, 0xF, 0xF, true));
  v += __uint_as_float(__builtin_amdgcn_update_dpp(0u, __float_as_uint(v), 0x140, 0xF, 0xF, true));
  return v;
}
__device__ __forceinline__ float half_sum(float v) {
  v = dpp_row_sum(v);
  return v + __shfl_xor(v, 16);
}
__device__ __forceinline__ float wave_sum(float v) {
  v = half_sum(v);
  auto r = __builtin_amdgcn_permlane32_swap(__float_as_uint(v), __float_as_uint(v), false, false);
  return __uint_as_float(r[0]) + __uint_as_float(r[1]);
}
__device__ __forceinline__ float sigmoidf_(float x) { return 1.f / (1.f + __expf(-x)); }
__device__ __forceinline__ float siluf_(float x) { return x / (1.f + __expf(-x)); }
__device__ __forceinline__ float geluf_(float x) {
  float u = 0.7978845608028654f * (x + 0.044715f * x * x * x);
  float e = __expf(2.f * u);
  float th = 1.f - 2.f / (e + 1.f);
  return 0.5f * x * (1.f + th);
}
__device__ __forceinline__ int t5_bucket(int n) {
  if (n < 16) return n < 0 ? 0 : n;
  float v = logf((float)n / 16.f) / 2.0794415416798357f * 16.f;
  int l = 16 + (int)v;
  return l > 31 ? 31 : l;
}
#define MFMA_BF16(a, b, c) __builtin_amdgcn_mfma_f32_32x32x16_bf16((a), (b), (c), 0, 0, 0)
#define MFMA_F16(a, b, c) __builtin_amdgcn_mfma_f32_32x32x16_f16((a), (b), (c), 0, 0, 0)

__device__ __forceinline__ int src_col(int job, int n) {
  switch (job) {
    case 0:
      if (n < 2560) return n;
      if (n < 3072) return 2584 + (n - 2560);
      if (n < 3328) return 3096 + (n - 3072);
      if (n < 3392) return 3352 + (n - 3328);
      if (n < 3416) return 2560 + (n - 3392);
      return -1;
    case 6:
      if (n < 1024) return (n >> 7) * 192 + (n & 127);
      return ((n - 1024) >> 6) * 192 + 128 + ((n - 1024) & 63);
    case 8:
      return n < 4176 ? n : -1;
    case 10: case 11: {
      int tl = n >> 7, w = n & 127;
      return w < 64 ? tl * 64 + w : 4096 + tl * 64 + (w - 64);
    }
    default: return n;
  }
}

struct WTile { const float* src; bf16_t* dst; const float* rs; int K, N, n0, k0, c; };
__device__ __forceinline__ void decode_wtile(const Params& p, int it, WTile& w) {
  int t = it, job;
  if (t < 1728) job = 0;
  else if ((t -= 1728) < 1024) job = 1;
  else if ((t -= 1024) < 256) job = 2;
  else if ((t -= 256) < 256) job = 3;
  else if ((t -= 256) < 8) job = 4;
  else if ((t -= 8) < 8) job = 5;
  else if ((t -= 8) < 192) job = 6;
  else if ((t -= 192) < 128) job = 7;
  else if ((t -= 128) < 2112) job = 8;
  else if ((t -= 2112) < 1024) job = 9;
  else if ((t -= 1024) < 4096) job = 10;
  else if ((t -= 4096) < 4096) job = 11;
  else if ((t -= 4096) < 2048) job = 12;
  else { t -= 2048; job = 13; }
  const float* src; bf16_t* dst; int K, N, NP; const float* rs = nullptr;
  unsigned char* ws = p.ws;
  switch (job) {
    case 0: src = p.in[I_EVIN]; dst = (bf16_t*)(ws + O_WEVIN); K = 2048; N = 3416; NP = 3456; break;
    case 1: src = p.in[I_EVOUT]; dst = (bf16_t*)(ws + O_WEVOUT); K = 2048; N = 2048; NP = 2048; break;
    case 2: src = p.in[I_CW1]; dst = (bf16_t*)(ws + O_WCW1); K = 4096; N = 256; NP = 256; break;
    case 3: src = p.in[I_CW1] + 4096 * 256; dst = (bf16_t*)(ws + O_WCW1) + 256 * 4096; K = 4096; N = 256; NP = 256; break;
    case 4: src = p.in[I_CW2]; dst = (bf16_t*)(ws + O_WCW2); K = 256; N = 128; NP = 128; break;
    case 5: src = p.in[I_CW2] + 256 * 128; dst = (bf16_t*)(ws + O_WCW2) + 128 * 256; K = 256; N = 128; NP = 128; break;
    case 6: src = p.in[I_WUQ]; dst = (bf16_t*)(ws + O_WUQ); K = 512; N = 1536; NP = 1536; rs = p.in[I_MQG]; break;
    case 7: src = p.in[I_WUKV]; dst = (bf16_t*)(ws + O_WUKV); K = 256; N = 2048; NP = 2048; rs = p.in[I_MKVG]; break;
    case 8: src = p.in[I_ODIN]; dst = (bf16_t*)(ws + O_WODIN); K = 2048; N = 4176; NP = 4224; break;
    case 9: src = p.in[I_ODOUT]; dst = (bf16_t*)(ws + O_WODOUT); K = 2048; N = 2048; NP = 2048; break;
    case 10: src = p.in[I_FUP]; dst = (bf16_t*)(ws + O_WUP); K = 2048; N = 8192; NP = 8192; break;
    case 11: src = p.in[I_FUP] + 2048ull * 8192; dst = (bf16_t*)(ws + O_WUP) + 8192ull * 2048; K = 2048; N = 8192; NP = 8192; break;
    case 12: src = p.in[I_FDOWN]; dst = (bf16_t*)(ws + O_WDOWN); K = 4096; N = 2048; NP = 2048; break;
    default: src = p.in[I_FDOWN] + 4096ull * 2048; dst = (bf16_t*)(ws + O_WDOWN) + 2048ull * 4096; K = 4096; N = 2048; NP = 2048; break;
  }
  (void)NP;
  const int ktiles = K >> 6;
  w.src = src; w.dst = dst; w.rs = rs; w.K = K; w.N = N;
  w.n0 = (t / ktiles) << 6; w.k0 = (t % ktiles) << 6;
  w.c = src_col(job, w.n0 + 4 * (TIDX & 15));
}
__device__ __forceinline__ void wtile_load(const WTile& w, float4 (&v)[4]) {
  const int tid = TIDX, cc = w.c >= 0 ? w.c : 0;
#pragma unroll
  for (int i = 0; i < 4; ++i) v[i] = *(const float4*)(w.src + (size_t)(w.k0 + (tid >> 4) + 16 * i) * w.N + cc);
}
__device__ __forceinline__ void wtile_to_lds(const WTile& w, const float4 (&v)[4], float* tl) {
  const int tid = TIDX, n4 = tid & 15;
#pragma unroll
  for (int i = 0; i < 4; ++i) {
    const int k = (tid >> 4) + 16 * i;
    float sc = (w.c >= 0) ? 1.f : 0.f;
    if (w.rs) sc *= w.rs[w.k0 + k];
    tl[k * 65 + 4 * n4 + 0] = v[i].x * sc; tl[k * 65 + 4 * n4 + 1] = v[i].y * sc;
    tl[k * 65 + 4 * n4 + 2] = v[i].z * sc; tl[k * 65 + 4 * n4 + 3] = v[i].w * sc;
  }
}
__device__ __forceinline__ void wtile_store(const WTile& w, const float* tl) {
  const int tid = TIDX, n = tid >> 2, kc = tid & 3;
  unsigned x[8];
#pragma unroll
  for (int j = 0; j < 8; ++j) x[j] = pack2(tl[(kc * 16 + 2 * j) * 65 + n], tl[(kc * 16 + 2 * j + 1) * 65 + n]);
  uint4* d = (uint4*)(w.dst + (size_t)(w.n0 + n) * w.K + w.k0 + kc * 16);
  d[0] = make_uint4(x[0], x[1], x[2], x[3]);
  d[1] = make_uint4(x[4], x[5], x[6], x[7]);
}

#define NW_TILES 19024
#define NADA_ITEMS 768
#define NCB1_ITEMS 32
#define NROPE_ITEMS 1536

__device__ __forceinline__ void phase_prep(const Params& p, unsigned char* smem) {
  const int total = NW_TILES + NADA_ITEMS + NCB1_ITEMS + NROPE_ITEMS;
  const int tid = TIDX;
#pragma unroll 1
  for (int it = blockIdx.x; it < NW_TILES; it += 2 * gridDim.x) {
    float* tl0 = (float*)smem; float* tl1 = tl0 + 64 * 65;
    const bool two = (it + (int)gridDim.x) < NW_TILES;
    WTile wa, wb;
    decode_wtile(p, it, wa);
    decode_wtile(p, two ? it + (int)gridDim.x : it, wb);
    float4 va[4], vb[4];
    wtile_load(wa, va);
    wtile_load(wb, vb);
    wtile_to_lds(wa, va, tl0);
    wtile_to_lds(wb, vb, tl1);
    __syncthreads();
    wtile_store(wa, tl0);
    if (two) wtile_store(wb, tl1);
    __syncthreads();
  }
  for (int it = NW_TILES + blockIdx.x; it < total; it += gridDim.x) {
    if (false) {
    } else if (it < NW_TILES + NADA_ITEMS) {
      int a = it - NW_TILES;
      int kc = a & 31; int cc = (a >> 5) % 6; int mat = a / (32 * 6);
      float* sc = (float*)smem;
      if (tid < 128) { int b = tid >> 6, k = tid & 63; sc[tid] = siluf_(p.in[I_C][b * 2048 + kc * 64 + k]); }
      __syncthreads();
      const float* W = p.in[I_ADAW] + (size_t)mat * 2048 * 6144 + (size_t)(kc * 64) * 6144 + cc * 1024 + tid * 4;
      float4 a0 = make_float4(0.f, 0.f, 0.f, 0.f), a1 = a0;
#pragma unroll 8
      for (int k = 0; k < 64; ++k) {
        float4 w = *(const float4*)(W + (size_t)k * 6144);
        float s0 = sc[k], s1 = sc[64 + k];
        a0.x += s0 * w.x; a0.y += s0 * w.y; a0.z += s0 * w.z; a0.w += s0 * w.w;
        a1.x += s1 * w.x; a1.y += s1 * w.y; a1.z += s1 * w.z; a1.w += s1 * w.w;
      }
      float* part = (float*)(p.ws + O_ADAP);
      *(float4*)(part + ((size_t)(mat * 32 + kc) * 2 + 0) * 6144 + cc * 1024 + tid * 4) = a0;
      *(float4*)(part + ((size_t)(mat * 32 + kc) * 2 + 1) * 6144 + cc * 1024 + tid * 4) = a1;
      __syncthreads();
    } else if (it < NW_TILES + NADA_ITEMS + NCB1_ITEMS) {
      int a = it - NW_TILES - NADA_ITEMS;
      int j = a >> 4, kc = a & 15;
      const float* pe = p.in[I_CPE] + j * 4096 + kc * 256;
      const float* W = p.in[I_CW1] + (size_t)j * 4096 * 256 + (size_t)(kc * 256) * 256 + tid;
      float acc = 0.f;
#pragma unroll 8
      for (int k = 0; k < 256; ++k) acc += pe[k] * W[(size_t)k * 256];
      ((float*)(p.ws + O_CB1PART))[(j * 16 + kc) * 256 + tid] = acc;
    } else {
      int a = it - NW_TILES - NADA_ITEMS - NCB1_ITEMS;
      int e = a * 256 + tid;
      int t = e / 48, i = e % 48;
      float inv; int half, fi;
      if (i < 32) { half = 32; fi = i; } else { half = 16; fi = i - 32; }
      inv = powf(10000.0f, -(float)fi / (float)half);
      float angf = (float)t * inv;
      double ad = (double)angf;
      double kk = rint(ad * 0.15915494309189535);
      float r = (float)(ad - kk * 6.283185307179586);
      float cs = __cosf(r), sn = __sinf(r);
      if (i < 32) {
        float* R = (float*)(p.ws + O_ROPE64);
        R[t * 32 + fi] = cs; R[8192 * 32 + t * 32 + fi] = sn;
      } else {
        float* R = (float*)(p.ws + O_ROPE32);
        R[t * 16 + fi] = cs; R[8192 * 16 + t * 16 + fi] = sn;
      }
    }
  }
}

__device__ __forceinline__ void phase_reduce(const Params& p) {
  const int gtid = blockIdx.x * blockDim.x + TIDX, gsz = gridDim.x * blockDim.x;
  const float* part = (const float*)(p.ws + O_ADAP);
  float* M = (float*)(p.ws + O_ADAM);
  for (int e = gtid; e < 4 * 2 * 6144; e += gsz) {
    int n = e % 6144; int b = (e / 6144) & 1; int mat = e / (2 * 6144);
    float s = p.in[I_ADAB][mat * 6144 + n];
    for (int kc = 0; kc < 32; ++kc) s += part[((size_t)(mat * 32 + kc) * 2 + b) * 6144 + n];
    M[e] = s;
  }
  const float* cp = (const float*)(p.ws + O_CB1PART);
  float* C = (float*)(p.ws + O_CB1P);
  for (int e = gtid; e < 512; e += gsz) {
    int j = e >> 8, c = e & 255;
    float s = p.in[I_CB1][e];
    for (int kc = 0; kc < 16; ++kc) s += cp[(j * 16 + kc) * 256 + c];
    C[e] = s;
  }
}

__device__ __forceinline__ void phase_norm(const Params& p, const float* X, int mat) {
  const int lane = TIDX & 63, wave = TIDX >> 6;
  const float* g = p.in[I_NORMG] + mat * 2048;
  const float* M = (const float*)(p.ws + O_ADAM) + (size_t)mat * 2 * 6144;
  bf16_t* H = (bf16_t*)(p.ws + O_H);
  const int stride = gridDim.x * 4;
  int row = blockIdx.x * 4 + wave;
  f32x4 vn[8];
  if (row < NTOK) {
#pragma unroll
    for (int i = 0; i < 8; ++i) vn[i] = __builtin_nontemporal_load((const f32x4*)(X + (size_t)row * 2048 + (i * 64 + lane) * 4));
  }
#pragma unroll 1
  for (; row < NTOK; row += stride) {
    const int b = row >> 13;
    f32x4 v[8]; float ss = 0.f;
#pragma unroll
    for (int i = 0; i < 8; ++i) { v[i] = vn[i]; ss += v[i].x * v[i].x + v[i].y * v[i].y + v[i].z * v[i].z + v[i].w * v[i].w; }
    {
      const int rn = (row + stride < NTOK) ? row + stride : row;
#pragma unroll
      for (int i = 0; i < 8; ++i) vn[i] = __builtin_nontemporal_load((const f32x4*)(X + (size_t)rn * 2048 + (i * 64 + lane) * 4));
    }
    ss = wave_sum(ss);
    const float rs = rsqrtf(ss * (1.f / 2048.f) + EPSF);
    const float* sh = M + b * 6144; const float* scl = sh + 2048;
#pragma unroll
    for (int i = 0; i < 8; ++i) {
      int c = (i * 64 + lane) * 4;
      float4 gg = *(const float4*)(g + c), s4 = *(const float4*)(scl + c), h4 = *(const float4*)(sh + c);
      float y0 = v[i].x * rs * gg.x * (1.f + s4.x) + h4.x;
      float y1 = v[i].y * rs * gg.y * (1.f + s4.y) + h4.y;
      float y2 = v[i].z * rs * gg.z * (1.f + s4.z) + h4.z;
      float y3 = v[i].w * rs * gg.w * (1.f + s4.w) + h4.w;
      { u32x2 hv = {pack2(y0, y1), pack2(y2, y3)}; __builtin_nontemporal_store(hv, (u32x2*)(H + (size_t)row * 2048 + c)); }
    }
  }
}

__device__ __forceinline__ void gemm_core(const bf16_t* __restrict__ A, long lda, int rowA0, int rowLo, int rowHi,
                                          const bf16_t* __restrict__ Bt, long ldb, int K, unsigned char* smem) {
  bf16_t* As = (bf16_t*)smem; bf16_t* Bs = As + 128 * 64;
  float* Cs = (float*)smem;
  const int tid = TIDX, lane = tid & 63, wave = tid >> 6;
  const int wm = wave >> 1, wn = wave & 1, l31 = lane & 31, hh = lane >> 5;
  f32x16 acc[2][2];
#pragma unroll
  for (int i = 0; i < 2; ++i)
#pragma unroll
    for (int j = 0; j < 2; ++j)
#pragma unroll
      for (int r = 0; r < 16; ++r) acc[i][j][r] = 0.f;
  u32x4 ra0[4], rb0[4], ra1[4], rb1[4];
#define GLOAD(RA, RB, KOFF)                                                                                   \
  _Pragma("unroll") for (int i = 0; i < 4; ++i) {                                                             \
    int c = tid + i * 256, row = c >> 3, kc = c & 7; int rr = rowA0 + row;                                    \
    u32x4 va = {0u, 0u, 0u, 0u};                                                                              \
    if (rr >= rowLo && rr < rowHi) va = *(const u32x4*)(A + (long)rr * lda + (KOFF) + kc * 8);                \
    RA[i] = va;                                                                                               \
    RB[i] = *(const u32x4*)(Bt + (long)row * ldb + (KOFF) + kc * 8);                                          \
  }
#define LSTORE(RA, RB)                                                                                        \
  _Pragma("unroll") for (int i = 0; i < 4; ++i) {                                                             \
    int c = tid + i * 256, row = c >> 3, kc = c & 7;                                                          \
    *(u32x4*)(As + row * 64 + ((kc ^ ((row >> 1) & 7)) << 3)) = RA[i];                                        \
    *(u32x4*)(Bs + row * 64 + ((kc ^ ((row >> 1) & 7)) << 3)) = RB[i];                                        \
  }
#define KSTEP()                                                                                               \
  __builtin_amdgcn_s_setprio(1);                                                                              \
  _Pragma("unroll") for (int ks = 0; ks < 4; ++ks) {                                                          \
    const int sw = (((ks * 2 + hh) ^ ((l31 >> 1) & 7)) << 3);                                                 \
    bf16x8 a0 = *(const bf16x8*)(As + (wm * 64 + l31) * 64 + sw);                                             \
    bf16x8 a1 = *(const bf16x8*)(As + (wm * 64 + 32 + l31) * 64 + sw);                                        \
    bf16x8 b0 = *(const bf16x8*)(Bs + (wn * 64 + l31) * 64 + sw);                                             \
    bf16x8 b1 = *(const bf16x8*)(Bs + (wn * 64 + 32 + l31) * 64 + sw);                                        \
    acc[0][0] = MFMA_BF16(a0, b0, acc[0][0]);                                                                 \
    acc[0][1] = MFMA_BF16(a0, b1, acc[0][1]);                                                                 \
    acc[1][0] = MFMA_BF16(a1, b0, acc[1][0]);                                                                 \
    acc[1][1] = MFMA_BF16(a1, b1, acc[1][1]);                                                                 \
  }                                                                                                           \
  __builtin_amdgcn_s_setprio(0);
  GLOAD(ra0, rb0, 0)
  GLOAD(ra1, rb1, 64)
#pragma unroll 1
  for (int k0 = 0; k0 < K; k0 += 128) {
    LSTORE(ra0, rb0)
    __syncthreads();
    if (k0 + 128 < K) { GLOAD(ra0, rb0, k0 + 128) }
    KSTEP()
    __syncthreads();
    LSTORE(ra1, rb1)
    __syncthreads();
    if (k0 + 192 < K) { GLOAD(ra1, rb1, k0 + 192) }
    KSTEP()
    __syncthreads();
  }
#undef GLOAD
#undef LSTORE
#undef KSTEP
#pragma unroll
  for (int i = 0; i < 2; ++i)
#pragma unroll
    for (int j = 0; j < 2; ++j)
#pragma unroll
      for (int r = 0; r < 16; ++r) {
        int row = wm * 64 + i * 32 + (r & 3) + 8 * (r >> 2) + 4 * hh;
        int col = wn * 64 + j * 32 + l31;
        Cs[row * 129 + col] = acc[i][j][r];
      }
  __syncthreads();
}

__device__ __forceinline__ void gemm_core2(const bf16_t* __restrict__ A, long lda, int rowA0, int rowLo, int rowHi,
                                           const bf16_t* __restrict__ Bt, long ldb, int K, unsigned char* smem, f32x16 (&acc)[2][4]) {
  bf16_t* As = (bf16_t*)smem; bf16_t* Bs = As + 128 * 64;
  const int tid = TIDX, lane = tid & 63, wave = tid >> 6;
  const int wm = wave >> 1, wn = wave & 1, l31 = lane & 31, hh = lane >> 5;
#pragma unroll
  for (int i = 0; i < 2; ++i)
#pragma unroll
    for (int j = 0; j < 4; ++j)
#pragma unroll
      for (int r = 0; r < 16; ++r) acc[i][j][r] = 0.f;
  u32x4 ra[4], rb[8];
#define GLOAD2(KOFF)                                                                                          \
  _Pragma("unroll") for (int i = 0; i < 4; ++i) {                                                             \
    int c = tid + i * 256, row = c >> 3, kc = c & 7; int rr = rowA0 + row;                                    \
    u32x4 va = {0u, 0u, 0u, 0u};                                                                              \
    if (rr >= rowLo && rr < rowHi) va = *(const u32x4*)(A + (long)rr * lda + (KOFF) + kc * 8);                \
    ra[i] = va;                                                                                               \
  }                                                                                                           \
  _Pragma("unroll") for (int i = 0; i < 8; ++i) {                                                             \
    int c = tid + i * 256, row = c >> 3, kc = c & 7;                                                          \
    rb[i] = *(const u32x4*)(Bt + (long)row * ldb + (KOFF) + kc * 8);                                          \
  }
  GLOAD2(0)
#pragma unroll 1
  for (int k0 = 0; k0 < K; k0 += 64) {
#pragma unroll
    for (int i = 0; i < 4; ++i) {
      int c = tid + i * 256, row = c >> 3, kc = c & 7;
      *(u32x4*)(As + row * 64 + ((kc ^ ((row >> 1) & 7)) << 3)) = ra[i];
    }
#pragma unroll
    for (int i = 0; i < 8; ++i) {
      int c = tid + i * 256, row = c >> 3, kc = c & 7;
      *(u32x4*)(Bs + row * 64 + ((kc ^ ((row >> 1) & 7)) << 3)) = rb[i];
    }
    __syncthreads();
    if (k0 + 64 < K) { GLOAD2(k0 + 64) }
    __builtin_amdgcn_s_setprio(1);
#pragma unroll
    for (int ks = 0; ks < 4; ++ks) {
      const int sw = (((ks * 2 + hh) ^ ((l31 >> 1) & 7)) << 3);
      bf16x8 a0 = *(const bf16x8*)(As + (wm * 64 + l31) * 64 + sw);
      bf16x8 a1 = *(const bf16x8*)(As + (wm * 64 + 32 + l31) * 64 + sw);
#pragma unroll
      for (int j = 0; j < 4; ++j) {
        bf16x8 bj = *(const bf16x8*)(Bs + (wn * 128 + j * 32 + l31) * 64 + sw);
        acc[0][j] = MFMA_BF16(a0, bj, acc[0][j]);
        acc[1][j] = MFMA_BF16(a1, bj, acc[1][j]);
      }
    }
    __builtin_amdgcn_s_setprio(0);
    __syncthreads();
  }
#undef GLOAD2
}
__device__ __forceinline__ void stage_half(const f32x16 (&acc)[2][4], int h, float* Cs) {
  const int tid = TIDX, lane = tid & 63, wave = tid >> 6;
  const int wm = wave >> 1, wn = wave & 1, l31 = lane & 31, hh = lane >> 5;
  if (wn == h) {
#pragma unroll
    for (int i = 0; i < 2; ++i)
#pragma unroll
      for (int j = 0; j < 4; ++j)
#pragma unroll
        for (int r = 0; r < 16; ++r)
          Cs[(wm * 64 + i * 32 + (r & 3) + 8 * (r >> 2) + 4 * hh) * 129 + j * 32 + l31] = acc[i][j][r];
  }
  __syncthreads();
}

#define CSV(r, c) Cs[(r) * 129 + (c)]

__device__ __forceinline__ void epi_rms128(const float* Cs, const float* g, bf16_t* dst, long dst_ld, const float* rowscale) {
  const int lane = TIDX & 63, wave = TIDX >> 6;
  const float g0 = g[2 * lane], g1 = g[2 * lane + 1];
#pragma unroll 1
  for (int i = 0; i < 32; ++i) {
    int r = wave * 32 + i;
    float v0 = CSV(r, 2 * lane), v1 = CSV(r, 2 * lane + 1);
    if (rowscale) { float s = rowscale[r]; v0 *= s; v1 *= s; }
    float ss = wave_sum(v0 * v0 + v1 * v1);
    float rs = rsqrtf(ss * (1.f / 128.f) + EPSF);
    *(unsigned*)(dst + (long)r * dst_ld + 2 * lane) = pack2(v0 * rs * g0, v1 * rs * g1);
  }
}
__device__ __forceinline__ void epi_raw(const float* Cs, bf16_t* dst, long dst_ld) {
  const int lane = TIDX & 63, wave = TIDX >> 6;
#pragma unroll 1
  for (int i = 0; i < 32; ++i) {
    int r = wave * 32 + i;
    *(unsigned*)(dst + (long)r * dst_ld + 2 * lane) = pack2(CSV(r, 2 * lane), CSV(r, 2 * lane + 1));
  }
}
__device__ __forceinline__ void epi_transposed(const float* Cs, bf16_t* dst, long dst_ld, const float* rowscale) {
  const int lane = TIDX & 63, wave = TIDX >> 6;
  float s0 = 1.f, s1 = 1.f;
  if (rowscale) { s0 = rowscale[2 * lane]; s1 = rowscale[2 * lane + 1]; }
#pragma unroll 1
  for (int i = 0; i < 32; ++i) {
    int d = wave * 32 + i;
    *(unsigned*)(dst + (long)d * dst_ld + 2 * lane) = pack2(CSV(2 * lane, d) * s0, CSV(2 * lane + 1, d) * s1);
  }
}

__device__ __forceinline__ void evin_epi(const Params& p, float* Cs, int tm, int tn) {
  unsigned char* ws = p.ws;
  const int lane = TIDX & 63, wave = TIDX >> 6;
  const float* rope = (const float*)(ws + O_ROPE64);
    const int tok0 = tm * 128, b = tok0 >> 13, t0 = tok0 & 8191;
    if (tn < 8) {
      epi_rms128(Cs, p.in[I_NSAG], (bf16_t*)(ws + O_QN) + ((size_t)(b * 8 + tn) * 8192 + t0) * 128, 128, nullptr);
    } else if (tn < 20) {
      int idx = tn - 8, j = idx >> 1, g = idx & 1;
      if (j < 2) epi_raw(Cs, (bf16_t*)(ws + O_KVSRC) + ((size_t)((j * 2 + b) * 2 + g) * 8192 + t0) * 128, 128);
      else if (j == 2) epi_rms128(Cs, p.in[I_NSAG] + 128, (bf16_t*)(ws + O_KSLC) + ((size_t)(b * 2 + g) * 8192 + t0) * 128, 128, nullptr);
      else if (j == 4) epi_rms128(Cs, p.in[I_NSAG] + 128, (bf16_t*)(ws + O_KWIN) + ((size_t)(b * 2 + g) * 8192 + t0) * 128, 128, nullptr);
      else if (j == 3) epi_transposed(Cs, (bf16_t*)(ws + O_VSLCT) + (size_t)(b * 2 + g) * 128 * 8192 + t0, 8192, nullptr);
      else epi_transposed(Cs, (bf16_t*)(ws + O_VWINT) + (size_t)(b * 2 + g) * 128 * 8192 + t0, 8192, nullptr);
    } else if (tn < 26) {
      bf16_t* dst; int ld, slot;
      if (tn < 24) { dst = (bf16_t*)(ws + O_CQ) + (size_t)tok0 * 512 + (tn - 20) * 128; ld = 512; slot = tn - 20; }
      else { dst = (bf16_t*)(ws + O_CKV) + (size_t)tok0 * 256 + (tn - 24) * 128; ld = 256; slot = 4 + tn - 24; }
      float* ssq = (float*)(ws + O_SSQ);
    #pragma unroll 1
  for (int i = 0; i < 32; ++i) {
        int r = wave * 32 + i;
        float v0 = CSV(r, 2 * lane), v1 = CSV(r, 2 * lane + 1);
        float ss = wave_sum(v0 * v0 + v1 * v1);
        *(unsigned*)(dst + (long)r * ld + 2 * lane) = pack2(v0, v1);
        if (lane == 0) ssq[(size_t)(tok0 + r) * 8 + slot] = ss;
      }
    } else {
      const float* g = p.in[I_ROPEG] + 64;
      const int c0 = 2 * (lane & 31);
      const float g0 = g[c0], g1 = g[c0 + 1];
      bf16_t* kml = (bf16_t*)(ws + O_KMLA);
      float* gates = (float*)(ws + O_GATES);
      const int ci = c0 & 31;
      float2 csn = *(const float2*)(rope + (t0 + wave * 32) * 32 + ci), snn = *(const float2*)(rope + 8192 * 32 + (t0 + wave * 32) * 32 + ci);
    #pragma unroll 1
  for (int i = 0; i < 32; ++i) {
        int r = wave * 32 + i, t = t0 + r;
        float v0 = CSV(r, 2 * lane), v1 = CSV(r, 2 * lane + 1);
        float ss = half_sum(v0 * v0 + v1 * v1);
        float rs = rsqrtf(ss * (1.f / 64.f) + EPSF);
        float y0 = v0 * rs * g0, y1 = v1 * rs * g1;
        float q0 = __shfl_xor(y0, 16), q1 = __shfl_xor(y1, 16);
        const float2 cs = csn, sn = snn;
        { const int tnx = (i + 1 < 32) ? t + 1 : t; csn = *(const float2*)(rope + tnx * 32 + ci); snn = *(const float2*)(rope + 8192 * 32 + tnx * 32 + ci); }
        if (lane < 32) {
          float o0, o1;
          if (lane < 16) { o0 = y0 * cs.x - q0 * sn.x; o1 = y1 * cs.y - q1 * sn.y; }
          else { o0 = q0 * sn.x + y0 * cs.x; o1 = q1 * sn.y + y1 * cs.y; }
          unsigned pk = pack2(o0, o1);
#pragma unroll
          for (int hd = 0; hd < 8; ++hd) *(unsigned*)(kml + ((size_t)(b * 8 + hd) * 8192 + t) * 192 + 128 + c0) = pk;
        } else if (lane < 44) {
          int gi = 2 * (lane - 32);
          gates[(size_t)(tok0 + r) * 24 + gi] = sigmoidf_(v0);
          gates[(size_t)(tok0 + r) * 24 + gi + 1] = sigmoidf_(v1);
        }
      }
    }
}
__device__ __forceinline__ void phase_evin(const Params& p, unsigned char* smem) {
  unsigned char* ws = p.ws;
  float* Cs = (float*)smem;
#pragma unroll 1
  for (int it = blockIdx.x; it < 128 * 12; it += gridDim.x) {
    const int tn2 = it % 12, tm = it / 12;
    f32x16 acc[2][4];
    gemm_core2((const bf16_t*)(ws + O_H), 2048, tm * 128, 0, NTOK, (const bf16_t*)(ws + O_WEVIN) + (size_t)tn2 * 256 * 2048, 2048, 2048, smem, acc);
#pragma unroll 1
    for (int h = 0; h < 2; ++h) {
      stage_half(acc, h, Cs);
      evin_epi(p, Cs, tm, tn2 * 2 + h);
      __syncthreads();
    }
  }
#pragma unroll 1
  for (int it = blockIdx.x; it < 128 * 3; it += gridDim.x) {
    const int tn = 24 + it % 3, tm = it / 3;
    gemm_core((const bf16_t*)(ws + O_H), 2048, tm * 128, 0, NTOK, (const bf16_t*)(ws + O_WEVIN) + (size_t)tn * 128 * 2048, 2048, 2048, smem);
    evin_epi(p, Cs, tm, tn);
    __syncthreads();
  }
}

__device__ __forceinline__ void phase_mid(const Params& p, unsigned char* smem) {
  unsigned char* ws = p.ws;
  float* Cs = (float*)smem;
  float* rsc = (float*)(smem + 66048);
  const int lane = TIDX & 63, wave = TIDX >> 6;
  const int n_cmp = 64, n_uq = 128 * 12, n_ukv = 128 * 16;
  const float* rope = (const float*)(ws + O_ROPE64);
  const float* ssq = (const float*)(ws + O_SSQ);
#pragma unroll 1
  for (int it = blockIdx.x; it < n_cmp; it += gridDim.x) {
    {
      int pidx = it >> 3, tm = (it >> 1) & 3, tn = it & 1;
      int j = pidx >> 2;
      gemm_core((const bf16_t*)(ws + O_KVSRC) + (size_t)pidx * 8192 * 128, 2048, tm * 128, 0, 511,
                (const bf16_t*)(ws + O_WCW1) + (size_t)j * 256 * 4096 + (size_t)tn * 128 * 4096, 4096, 4096, smem);
      const float* cb = (const float*)(ws + O_CB1P) + j * 256 + tn * 128;
      bf16_t* hid = (bf16_t*)(ws + O_HID) + ((size_t)pidx * 512 + tm * 128) * 256 + tn * 128;
      const float b0 = cb[2 * lane], b1 = cb[2 * lane + 1];
    #pragma unroll 1
  for (int i = 0; i < 32; ++i) {
        int r = wave * 32 + i;
        *(unsigned*)(hid + (long)r * 256 + 2 * lane) = pack2(geluf_(CSV(r, 2 * lane) + b0), geluf_(CSV(r, 2 * lane + 1) + b1));
      }
    }
    __syncthreads();
  }
#pragma unroll 1
  for (int it = blockIdx.x; it < n_uq; it += gridDim.x) {
    {
      int a = it; int tn = a % 12, tm = a / 12;
      gemm_core((const bf16_t*)(ws + O_CQ), 512, tm * 128, 0, NTOK, (const bf16_t*)(ws + O_WUQ) + (size_t)tn * 128 * 512, 512, 512, smem);
      const int tok0 = tm * 128, b = tok0 >> 13, t0 = tok0 & 8191;
      if (TIDX < 128) {
        const float* s = ssq + (size_t)(tok0 + TIDX) * 8;
        rsc[TIDX] = rsqrtf((s[0] + s[1] + s[2] + s[3]) * (1.f / 512.f) + EPSF);
      }
      __syncthreads();
      bf16_t* qm = (bf16_t*)(ws + O_QMLA);
      if (tn < 8) {
        epi_rms128(Cs, p.in[I_NOPEG], qm + ((size_t)(b * 8 + tn) * 8192 + t0) * 192, 192, rsc);
      } else {
        const float* g = p.in[I_ROPEG];
        const int c0 = 2 * (lane & 31), hd = 2 * (tn - 8) + (lane >> 5), l31 = lane & 31;
        const float g0 = g[c0], g1 = g[c0 + 1];
        const int ci = c0 & 31;
        float2 csn = *(const float2*)(rope + (t0 + wave * 32) * 32 + ci), snn = *(const float2*)(rope + 8192 * 32 + (t0 + wave * 32) * 32 + ci);
      #pragma unroll 1
  for (int i = 0; i < 32; ++i) {
          int r = wave * 32 + i, t = t0 + r;
          float sc = rsc[r];
          float v0 = CSV(r, 2 * lane) * sc, v1 = CSV(r, 2 * lane + 1) * sc;
          float ss = half_sum(v0 * v0 + v1 * v1);
          float rs = rsqrtf(ss * (1.f / 64.f) + EPSF);
          float y0 = v0 * rs * g0, y1 = v1 * rs * g1;
          float q0 = __shfl_xor(y0, 16), q1 = __shfl_xor(y1, 16);
          const float2 cs = csn, sn = snn;
          { const int tnx = (i + 1 < 32) ? t + 1 : t; csn = *(const float2*)(rope + tnx * 32 + ci); snn = *(const float2*)(rope + 8192 * 32 + tnx * 32 + ci); }
          float o0, o1;
          if (l31 < 16) { o0 = y0 * cs.x - q0 * sn.x; o1 = y1 * cs.y - q1 * sn.y; }
          else { o0 = q0 * sn.x + y0 * cs.x; o1 = q1 * sn.y + y1 * cs.y; }
          *(unsigned*)(qm + ((size_t)(b * 8 + hd) * 8192 + t) * 192 + 128 + c0) = pack2(o0, o1);
        }
      }
    }
    __syncthreads();
  }
#pragma unroll 1
  for (int it = blockIdx.x; it < n_ukv; it += gridDim.x) {
    {
      int a = it; int tn = a & 15, tm = a >> 4;
      gemm_core((const bf16_t*)(ws + O_CKV), 256, tm * 128, 0, NTOK, (const bf16_t*)(ws + O_WUKV) + (size_t)tn * 128 * 256, 256, 256, smem);
      const int tok0 = tm * 128, b = tok0 >> 13, t0 = tok0 & 8191, hd = tn >> 1;
      if (TIDX < 128) {
        const float* s = ssq + (size_t)(tok0 + TIDX) * 8;
        rsc[TIDX] = rsqrtf((s[4] + s[5]) * (1.f / 256.f) + EPSF);
      }
      __syncthreads();
      if ((tn & 1) == 0) epi_rms128(Cs, p.in[I_NOPEG] + 128, (bf16_t*)(ws + O_KMLA) + ((size_t)(b * 8 + hd) * 8192 + t0) * 192, 192, rsc);
      else epi_transposed(Cs, (bf16_t*)(ws + O_VMLAT) + (size_t)(b * 8 + hd) * 128 * 8192 + t0, 8192, rsc);
    }
    __syncthreads();
  }
}

__device__ __forceinline__ void phase_cmp2(const Params& p, unsigned char* smem) {
  unsigned char* ws = p.ws;
  float* Cs = (float*)smem;
  const int lane = TIDX & 63, wave = TIDX >> 6;
  for (int it = blockIdx.x; it < 32; it += gridDim.x) {
    int pidx = it >> 2, tm = it & 3;
    int j = pidx >> 2, bg = pidx & 3;
    gemm_core((const bf16_t*)(ws + O_HID) + (size_t)pidx * 512 * 256, 256, tm * 128, 0, 512,
              (const bf16_t*)(ws + O_WCW2) + (size_t)j * 128 * 256, 256, 256, smem);
    const float* b2 = p.in[I_CB2] + j * 128;
  #pragma unroll 1
  for (int i = 0; i < 32; ++i) {
      int r = wave * 32 + i;
      CSV(r, 2 * lane) += b2[2 * lane]; CSV(r, 2 * lane + 1) += b2[2 * lane + 1];
    }
    __syncthreads();
    if (j == 0) epi_rms128(Cs, p.in[I_NSAG] + 128, (bf16_t*)(ws + O_KCMP) + ((size_t)bg * 512 + tm * 128) * 128, 128, nullptr);
    else epi_transposed(Cs, (bf16_t*)(ws + O_VCMPT) + (size_t)bg * 128 * 512 + tm * 128, 512, nullptr);
    __syncthreads();
  }
}

__device__ __forceinline__ void phase_resid(const Params& p, const bf16_t* A, int K, const bf16_t* Bt, const float* src, float* dst, int mat, unsigned char* smem) {
  float* Cs = (float*)smem;
  const int lane = TIDX & 63, wave = TIDX >> 6;
  const float* M = (const float*)(p.ws + O_ADAM) + (size_t)mat * 2 * 6144;
  for (int it = blockIdx.x; it < 128 * 8; it += gridDim.x) {
    const int tn2 = it & 7, tm = it >> 3;
    f32x16 acc[2][4];
    gemm_core2(A, K, tm * 128, 0, NTOK, Bt + (size_t)tn2 * 256 * K, K, K, smem, acc);
#pragma unroll 1
    for (int h = 0; h < 2; ++h) {
    stage_half(acc, h, Cs);
    const int tn = tn2 * 2 + h;
    const int tok0 = tm * 128, b = tok0 >> 13;
    const int col = tn * 128 + 2 * lane;
    const float g0 = M[b * 6144 + 4096 + col], g1 = M[b * 6144 + 4096 + col + 1];
#pragma unroll 1
    for (int i0 = 0; i0 < 32; i0 += 8) {
      f32x2_t sv[8];
#pragma unroll
      for (int j = 0; j < 8; ++j) sv[j] = *(const f32x2_t*)(src + (size_t)(tok0 + wave * 32 + i0 + j) * 2048 + col);
#pragma unroll
      for (int j = 0; j < 8; ++j) {
        const int r = wave * 32 + i0 + j;
        f32x2_t d = {sv[j].x + g0 * CSV(r, 2 * lane), sv[j].y + g1 * CSV(r, 2 * lane + 1)};
        *(f32x2_t*)(dst + (size_t)(tok0 + r) * 2048 + col) = d;
      }
    }
    __syncthreads();
    }
  }
}

__device__ __forceinline__ void phase_ffn_up(const Params& p, int layer, unsigned char* smem) {
  float* Cs = (float*)smem;
  const int lane = TIDX & 63, wave = TIDX >> 6;
  const bf16_t* Bt = (const bf16_t*)(p.ws + O_WUP) + (size_t)layer * 8192 * 2048;
  const float* cw = p.in[I_FCW] + (size_t)layer * 3 * 8192;
  const float* cb = p.in[I_FCB] + (size_t)layer * 8192;
  bf16_t* act = (bf16_t*)(p.ws + O_ACT);
  for (int it = blockIdx.x; it < 132 * 32; it += gridDim.x) {
    const int tn2 = it & 31, tmi = it >> 5;
    const int b = tmi / 66, i66 = tmi % 66;
    const int rowA0 = b * 8192 + i66 * 126 - 2;
    f32x16 acc[2][4];
    gemm_core2((const bf16_t*)(p.ws + O_H), 2048, rowA0, b * 8192, (b + 1) * 8192, Bt + (size_t)tn2 * 256 * 2048, 2048, 2048, smem, acc);
#pragma unroll 1
    for (int h = 0; h < 2; ++h) {
    stage_half(acc, h, Cs);
    const int tn = tn2 * 2 + h;
    const int cg_ = tn * 64 + lane, cv_ = 4096 + tn * 64 + lane;
    const float wg0 = cw[cg_], wg1 = cw[8192 + cg_], wg2 = cw[16384 + cg_], bg = cb[cg_];
    const float wv0 = cw[cv_], wv1 = cw[8192 + cv_], wv2 = cw[16384 + cv_], bv = cb[cv_];
  #pragma unroll 1
  for (int i = 0; i < 32; ++i) {
      int r = wave * 32 + i;
      if (r < 2) continue;
      int tok = rowA0 + r;
      if (tok >= (b + 1) * 8192) continue;
      float ug = wg0 * CSV(r - 2, lane) + wg1 * CSV(r - 1, lane) + wg2 * CSV(r, lane) + bg;
      float uv = wv0 * CSV(r - 2, 64 + lane) + wv1 * CSV(r - 1, 64 + lane) + wv2 * CSV(r, 64 + lane) + bv;
      act[(size_t)tok * 4096 + tn * 64 + lane] = f2bf(siluf_(ug) * uv);
    }
    __syncthreads();
    }
  }
}

__device__ __forceinline__ void odin_epi(const Params& p, float* Cs, int tm, int tn) {
  unsigned char* ws = p.ws;
  const int lane = TIDX & 63, wave = TIDX >> 6;
  const float* rope = (const float*)(ws + O_ROPE32);
    const int tok0 = tm * 128, b = tok0 >> 13, t0 = tok0 & 8191;
    if (tn < 16) {
      epi_rms128(Cs, p.in[I_DSAG], (bf16_t*)(ws + O_QD) + ((size_t)(b * 16 + tn) * 8192 + t0) * 128, 128, nullptr);
    } else if (tn < 20) {
      epi_rms128(Cs, p.in[I_DSAG] + 128, (bf16_t*)(ws + O_KD) + ((size_t)(b * 4 + tn - 16) * 8192 + t0) * 128, 128, nullptr);
    } else if (tn < 24) {
      epi_transposed(Cs, (bf16_t*)(ws + O_VDT) + (size_t)(b * 4 + tn - 20) * 128 * 8192 + t0, 8192, nullptr);
    } else {
      const int l31 = lane & 31, c0 = 2 * l31;
      _Float16* iq = (_Float16*)(ws + O_IQ);
      _Float16* ik = (_Float16*)(ws + O_IK);
      float* iw = (float*)(ws + O_IW);
      const int ci = c0 & 15;
      float2 csn = *(const float2*)(rope + (t0 + wave * 32) * 16 + ci), snn = *(const float2*)(rope + 8192 * 16 + (t0 + wave * 32) * 16 + ci);
    #pragma unroll 1
  for (int i = 0; i < 32; ++i) {
        int r = wave * 32 + i, t = t0 + r;
        float v0 = CSV(r, 2 * lane), v1 = CSV(r, 2 * lane + 1);
        float q0 = __shfl_xor(v0, 8), q1 = __shfl_xor(v1, 8);
        float o0 = v0, o1 = v1;
        const float2 cs = csn, sn = snn;
        { const int tnx = (i + 1 < 32) ? t + 1 : t; csn = *(const float2*)(rope + tnx * 16 + ci); snn = *(const float2*)(rope + 8192 * 16 + tnx * 16 + ci); }
        if (l31 < 8) { o0 = v0 * cs.x - q0 * sn.x; o1 = v1 * cs.y - q1 * sn.y; }
        else if (l31 < 16) { o0 = q0 * sn.x + v0 * cs.x; o1 = q1 * sn.y + v1 * cs.y; }
        if (tn < 32) {
          int ih = 2 * (tn - 24) + (lane >> 5);
          _Float16* d = iq + ((size_t)(tok0 + r) * 16 + ih) * 64 + c0;
          d[0] = (_Float16)(o0 * 0.125f); d[1] = (_Float16)(o1 * 0.125f);
        } else if (lane < 32) {
          _Float16* d = ik + (size_t)(tok0 + r) * 64 + c0;
          d[0] = (_Float16)o0; d[1] = (_Float16)o1;
        } else if (lane < 40) {
          int wi = 2 * (lane - 32);
          iw[(size_t)(tok0 + r) * 16 + wi] = v0 * 0.25f;
          iw[(size_t)(tok0 + r) * 16 + wi + 1] = v1 * 0.25f;
        }
      }
    }
}
__device__ __forceinline__ void phase_odin(const Params& p, unsigned char* smem) {
  unsigned char* ws = p.ws;
  float* Cs = (float*)smem;
#pragma unroll 1
  for (int it = blockIdx.x; it < 128 * 16; it += gridDim.x) {
    const int tn2 = it & 15, tm = it >> 4;
    f32x16 acc[2][4];
    gemm_core2((const bf16_t*)(ws + O_H), 2048, tm * 128, 0, NTOK, (const bf16_t*)(ws + O_WODIN) + (size_t)tn2 * 256 * 2048, 2048, 2048, smem, acc);
#pragma unroll 1
    for (int h = 0; h < 2; ++h) {
      stage_half(acc, h, Cs);
      odin_epi(p, Cs, tm, tn2 * 2 + h);
      __syncthreads();
    }
  }
#pragma unroll 1
  for (int tm = blockIdx.x; tm < 128; tm += gridDim.x) {
    gemm_core((const bf16_t*)(ws + O_H), 2048, tm * 128, 0, NTOK, (const bf16_t*)(ws + O_WODIN) + (size_t)32 * 128 * 2048, 2048, 2048, smem);
    odin_epi(p, Cs, tm, 32);
    __syncthreads();
  }
}

template <int DQK>
__device__ __forceinline__ void compute_st(const bf16_t* Ks, int kb, const bf16x8 (&qf)[8], const bf16_t* Qs, int l31, int hh, f32x16& st) {
#pragma unroll
  for (int r = 0; r < 16; ++r) st[r] = 0.f;
  __builtin_amdgcn_s_setprio(1);
#pragma unroll
  for (int ks = 0; ks < DQK / 16; ++ks) {
    bf16x8 a0 = *(const bf16x8*)(Ks + (kb * 32 + l31) * (DQK + 8) + ks * 16 + hh * 8);
    bf16x8 bq;
    if (ks < 8) bq = qf[ks < 8 ? ks : 0];
    else bq = *(const bf16x8*)(Qs + (ks - 8) * 16 + hh * 8);
    st = MFMA_BF16(a0, bq, st);
  }
  __builtin_amdgcn_s_setprio(0);
}

template <int MODE>
__device__ __forceinline__ float mask_val(float sraw, int d, float scale, const float* lut, bool far, float lutfar, bool tilebit, unsigned mw, int bitpos) {
  bool ok = d >= 0;
  if (MODE == 1) ok = ok && d < 512;
  if (MODE == 2) ok = ok && tilebit;
  if (MODE == 3) ok = ok && ((mw >> bitpos) & 1u);
  float bias = 0.f;
  if (MODE != 0) {
    if (far) bias = lutfar;
    else { int di = d < 0 ? 0 : (d > 128 ? 128 : d); bias = lut[di]; }
  }
  return ok ? sraw * scale + bias : NEG_INF;
}

template <int DQK, int MODE>
__device__ __forceinline__ void flash_loop(const bf16_t* __restrict__ Kg, const bf16_t* __restrict__ Vtg, int vt_ld, int kt_lo, int kt_hi,
                                           const bf16x8 (&qf)[8], const bf16_t* Qs, int t, int tmin_wave, float scale, const float* lut,
                                           u64 sel0, u64 sel1, const u64* mrow, unsigned char* smem,
                                           f32x16 (&o)[4], float& m_run, float& l_run) {
  constexpr int LDK = DQK + 8, KCH = DQK / 8, NKC = 64 * KCH / 256;
  bf16_t* Ks = (bf16_t*)smem; bf16_t* Vs = Ks + 64 * LDK;
  constexpr int VLD = 68;
  const int tid = TIDX, lane = tid & 63, l31 = lane & 31, hh = lane >> 5;
  const float lutfar = (MODE != 0) ? lut[128] : 0.f;
  const float scale2 = scale * LOG2E;
#pragma unroll
  for (int i = 0; i < 4; ++i) {
#pragma unroll
    for (int r = 0; r < 16; ++r) o[i][r] = 0.f;
  }
  m_run = NEG_INF; l_run = 0.f;
  constexpr bool PREF = (MODE != 4);
  u32x4 pk[4], pv[4];
  u64 mw_next = 0;
  if (PREF && kt_lo < kt_hi) {
#pragma unroll
    for (int i = 0; i < 4; ++i) { int row = (tid >> 4) + i * 16, cc = tid & 15; pk[i] = *(const u32x4*)(Kg + (size_t)(kt_lo * 64 + row) * DQK + cc * 8); }
    {
#pragma unroll
      for (int i = 0; i < 4; ++i) { int c = tid + i * 256, row = c >> 3, cc = c & 7; pv[i] = *(const u32x4*)(Vtg + (size_t)row * vt_ld + kt_lo * 64 + cc * 8); }
    }
    if (MODE == 3) mw_next = mrow[kt_lo];
  }
#pragma unroll 1
  for (int kt = kt_lo; kt < kt_hi; ++kt) {
    __syncthreads();
    u64 mw = 0;
    if (PREF) {
#pragma unroll
      for (int i = 0; i < 4; ++i) { int row = (tid >> 4) + i * 16, cc = tid & 15; *(u32x4*)(Ks + row * LDK + cc * 8) = pk[i]; }
      if (DQK > 128) {
#pragma unroll
        for (int i = 0; i < 2; ++i) { int row = (tid >> 3) + i * 32, cc = 16 + (tid & 7); *(u32x4*)(Ks + row * LDK + cc * 8) = *(const u32x4*)(Kg + (size_t)(kt * 64 + row) * DQK + cc * 8); }
      }
      {
#pragma unroll
        for (int i = 0; i < 4; ++i) { int c = tid + i * 256, row = c >> 3, cc = c & 7; u32x2 lo2 = {pv[i].x, pv[i].y}, hi2 = {pv[i].z, pv[i].w}; *(u32x2*)(Vs + row * VLD + cc * 8) = lo2; *(u32x2*)(Vs + row * VLD + cc * 8 + 4) = hi2; }
      }
      mw = mw_next;
    } else {
#pragma unroll
      for (int i = 0; i < 4; ++i) { int row = (tid >> 4) + i * 16, cc = tid & 15; *(u32x4*)(Ks + row * LDK + cc * 8) = *(const u32x4*)(Kg + (size_t)(kt * 64 + row) * DQK + cc * 8); }
      if (DQK > 128) {
#pragma unroll
        for (int i = 0; i < 2; ++i) { int row = (tid >> 3) + i * 32, cc = 16 + (tid & 7); *(u32x4*)(Ks + row * LDK + cc * 8) = *(const u32x4*)(Kg + (size_t)(kt * 64 + row) * DQK + cc * 8); }
      }
#pragma unroll
      for (int i = 0; i < 4; ++i) { int c = tid + i * 256, row = c >> 3, cc = c & 7; const u32x4 t4 = *(const u32x4*)(Vtg + (size_t)row * vt_ld + kt * 64 + cc * 8); u32x2 lo2 = {t4.x, t4.y}, hi2 = {t4.z, t4.w}; *(u32x2*)(Vs + row * VLD + cc * 8) = lo2; *(u32x2*)(Vs + row * VLD + cc * 8 + 4) = hi2; }
      if (MODE == 3) mw = mrow[kt];
    }
    __syncthreads();
    if (PREF && kt + 1 < kt_hi) {
#pragma unroll
      for (int i = 0; i < 4; ++i) { int row = (tid >> 4) + i * 16, cc = tid & 15; pk[i] = *(const u32x4*)(Kg + (size_t)((kt + 1) * 64 + row) * DQK + cc * 8); }
      {
#pragma unroll
        for (int i = 0; i < 4; ++i) { int c = tid + i * 256, row = c >> 3, cc = c & 7; pv[i] = *(const u32x4*)(Vtg + (size_t)row * vt_ld + (kt + 1) * 64 + cc * 8); }
      }
      if (MODE == 3) mw_next = mrow[kt + 1];
    }
    bool tilebit = true;
    if (MODE == 2) tilebit = kt < 64 ? ((sel0 >> kt) & 1ull) : ((sel1 >> (kt - 64)) & 1ull);
    bool far = false;
    if (MODE == 4) far = (tmin_wave - (16 * (kt * 64 + 63) + 31)) >= 128;
    else if (MODE != 0) far = (tmin_wave - (kt * 64 + 63)) >= 128;
#pragma unroll
    for (int kb = 0; kb < 2; ++kb) {
      f32x16 st;
      compute_st<DQK>(Ks, kb, qf, Qs, l31, hh, st);
      __builtin_amdgcn_sched_barrier(0);
      const unsigned mb = (unsigned)(mw >> (32 * kb + 4 * hh));
      const int smax = kt * 64 + kb * 32 + 31, smin = kt * 64 + kb * 32;
      bool fast;
      if (MODE == 4) fast = (tmin_wave - (16 * smax + 31)) >= 128;
      else if (MODE == 0) fast = tmin_wave >= smax;
      else if (MODE == 1) fast = (tmin_wave - smax) >= 128 && (tmin_wave + 31 - smin) < 512;
      else fast = (tmin_wave - smax) >= 128;
      float mxs;
      if (fast) {
        float mx = NEG_INF;
#pragma unroll
        for (int r = 0; r < 16; ++r) {
          const int cr = (r & 3) + 8 * (r >> 2);
          float v = st[r];
          if (MODE == 3) v = ((mb >> cr) & 1u) ? v : NEG_INF;
          if (MODE == 2) v = tilebit ? v : NEG_INF;
          st[r] = v;
          mx = fmaxf(mx, v);
        }
        mxs = mx * scale2 + lutfar;
      } else {
        int dbase = (MODE == 4) ? (t - 31 - 16 * (kt * 64 + kb * 32 + 4 * hh)) : (t - 4 * hh - kt * 64 - kb * 32);
        asm volatile("" : "+v"(dbase));
        float mx = NEG_INF;
#pragma unroll
        for (int r = 0; r < 16; ++r) {
          const int cr = (r & 3) + 8 * (r >> 2);
          const int d0 = (MODE == 4) ? dbase - 16 * cr : dbase - cr;
          st[r] = mask_val<MODE>(st[r], d0, scale2, lut, far, lutfar, tilebit, mb, cr);
          mx = fmaxf(mx, st[r]);
        }
        mxs = mx;
      }
      mxs = xmax32(mxs);
      const float m_new = (mxs > m_run + 8.0f) ? mxs : m_run;
      const float m_use = (m_new == NEG_INF) ? 0.f : m_new;
      const float alpha = EXP2F(m_run - m_use);
      float rowsum = 0.f;
      if (fast) {
        const float c0 = lutfar - m_use;
#pragma unroll
        for (int r = 0; r < 16; ++r) { st[r] = EXP2F(__builtin_fmaf(st[r], scale2, c0)); rowsum += st[r]; }
      } else {
#pragma unroll
        for (int r = 0; r < 16; ++r) { st[r] = EXP2F(st[r] - m_use); rowsum += st[r]; }
      }
      l_run = l_run * alpha + rowsum;
      if (!__all(m_new == m_run)) {
#pragma unroll
        for (int i = 0; i < 4; ++i) {
#pragma unroll
          for (int r = 0; r < 16; ++r) o[i][r] *= alpha;
        }
      }
      m_run = m_new;
      __builtin_amdgcn_sched_barrier(0);
      __builtin_amdgcn_s_setprio(1);
#pragma unroll
      for (int s2 = 0; s2 < 2; ++s2) {
        u32x4 pw = {pack2(st[8 * s2], st[8 * s2 + 1]), pack2(st[8 * s2 + 2], st[8 * s2 + 3]),
                    pack2(st[8 * s2 + 4], st[8 * s2 + 5]), pack2(st[8 * s2 + 6], st[8 * s2 + 7])};
        bf16x8 pf = __builtin_bit_cast(bf16x8, pw);
#pragma unroll
        for (int dt = 0; dt < 4; ++dt) {
          const bf16_t* vp = Vs + (dt * 32 + l31) * VLD + kb * 32 + 16 * s2 + 4 * hh;
          s16x4 lo = *(const s16x4*)vp, hi = *(const s16x4*)(vp + 8);
          bf16x8 a = __builtin_shufflevector(lo, hi, 0, 1, 2, 3, 4, 5, 6, 7);
          o[dt] = MFMA_BF16(a, pf, o[dt]);
        }
      }
      __builtin_amdgcn_s_setprio(0);
      __builtin_amdgcn_sched_barrier(0);
    }
  }
  l_run = xsum32(l_run);
}

__device__ __forceinline__ void load_q(const bf16_t* Qrow, int hh, bf16x8 (&qf)[8]) {
#pragma unroll
  for (int ks = 0; ks < 8; ++ks) qf[ks] = *(const bf16x8*)(Qrow + ks * 16 + hh * 8);
}

__device__ __forceinline__ void build_lut(const Params& p, float* lut, int head) {
  if (TIDX < 129) lut[TIDX] = p.in[I_REL][t5_bucket(TIDX) * 16 + head] * LOG2E;
}

#define LUT_OFF 45056
#define IMP_OFF 46080
#define SCR_OFF 62592

__device__ __forceinline__ void phase_cmp_attn(const Params& p, unsigned char* smem) {
  unsigned char* ws = p.ws;
  const int tid = TIDX, lane = tid & 63, wave = tid >> 6, l31 = lane & 31, hh = lane >> 5;
  float* lut4 = (float*)(smem + LUT_OFF);
  float* imp = (float*)(smem + IMP_OFF);
  float* scr = (float*)(smem + SCR_OFF);
  float* lutw = (float*)(smem + SCR_OFF + 2048);
  (void)lut4;
  const float scale = 0.08838834764831845f;
  SNAKE_LOOP(it, 1024) {
    const int qt = 255 - (it >> 2), bg = it & 3, b = bg >> 1, g = bg & 1;
    const int q0 = qt * 32, t = q0 + l31, head = g * 4 + wave;
    __syncthreads();
    for (int e = tid; e < 4 * 129; e += 256) { int hd = e / 129, d = e % 129; lutw[e] = p.in[I_REL][t5_bucket(d) * 16 + g * 4 + hd] * LOG2E; }
    for (int e = tid; e < 32 * 129; e += 256) imp[e] = 0.f;
    __syncthreads();
    const float* lut = lutw + wave * 129;
    const bf16_t* Kg = (const bf16_t*)(ws + O_KCMP) + (size_t)bg * 512 * 128;
    const bf16_t* Vtg = (const bf16_t*)(ws + O_VCMPT) + (size_t)bg * 128 * 512;
    bf16x8 qf[8];
    load_q((const bf16_t*)(ws + O_QN) + ((size_t)(b * 8 + head) * 8192 + t) * 128, hh, qf);
    const int kt_hi = (q0 >> 10) + 1;
    f32x16 o[4]; float m_run, l_run;
    flash_loop<128, 4>(Kg, Vtg, 512, 0, kt_hi, qf, nullptr, t, q0, scale, lut, 0, 0, nullptr, smem, o, m_run, l_run);
    const float inv_l = l_run > 0.f ? 1.f / l_run : 0.f;
    {
      const float gc = ((const float*)(ws + O_GATES))[(size_t)(b * 8192 + t) * 24 + head * 3 + 0] * inv_l;
      float* oc = (float*)(ws + O_OC) + (size_t)(b * 8192 + t) * 1024 + head * 128;
#pragma unroll
      for (int dt = 0; dt < 4; ++dt)
#pragma unroll
        for (int rq = 0; rq < 4; ++rq) {
          float4 v = make_float4(o[dt][rq * 4] * gc, o[dt][rq * 4 + 1] * gc, o[dt][rq * 4 + 2] * gc, o[dt][rq * 4 + 3] * gc);
          *(float4*)(oc + dt * 32 + 8 * rq + 4 * hh) = v;
        }
    }
    bf16_t* Ks = (bf16_t*)smem;
    const float m_use = (m_run == NEG_INF) ? 0.f : m_run;
    for (int kt = 0; kt < kt_hi; ++kt) {
      __syncthreads();
#pragma unroll
      for (int i = 0; i < 4; ++i) { int c = tid + i * 256, row = c >> 4, cc = c & 15; *(u32x4*)(Ks + row * 136 + cc * 8) = *(const u32x4*)(Kg + (size_t)(kt * 64 + row) * 128 + cc * 8); }
      __syncthreads();
      const bool far = (q0 - (16 * (kt * 64 + 63) + 31)) >= 128;
      const float lutfar = lut[128];
      f32x16 st0, st1;
      compute_st<128>(Ks, 0, qf, nullptr, l31, hh, st0);
      compute_st<128>(Ks, 1, qf, nullptr, l31, hh, st1);
      int dbase = t - 31 - 16 * (kt * 64 + 4 * hh);
      asm volatile("" : "+v"(dbase));
#pragma unroll
      for (int r = 0; r < 16; ++r) {
        const int cr = (r & 3) + 8 * (r >> 2);
        st0[r] = EXP2F(mask_val<4>(st0[r], dbase - 16 * cr, scale * LOG2E, lut, far, lutfar, true, 0u, 0) - m_use) * inv_l;
        st1[r] = EXP2F(mask_val<4>(st1[r], dbase - 16 * cr - 512, scale * LOG2E, lut, far, lutfar, true, 0u, 0) - m_use) * inv_l;
      }
      for (int w = 0; w < 4; ++w) {
        if (wave == w) {
#pragma unroll
          for (int kb = 0; kb < 2; ++kb) {
#pragma unroll
            for (int rq = 0; rq < 4; ++rq) {
              float p0 = kb ? st1[rq * 4] : st0[rq * 4], p1 = kb ? st1[rq * 4 + 1] : st0[rq * 4 + 1];
              float p2 = kb ? st1[rq * 4 + 2] : st0[rq * 4 + 2], p3 = kb ? st1[rq * 4 + 3] : st0[rq * 4 + 3];
              int n = kt * 16 + kb * 8 + 2 * rq + hh;
              float mainv = p0 + p1 + p2 + 0.5f * p3;
              imp[l31 * 129 + n] += mainv;
              __builtin_amdgcn_s_waitcnt(0xc07f);
              imp[l31 * 129 + n + 1] += 0.5f * p3;
              __builtin_amdgcn_s_waitcnt(0xc07f);
            }
          }
        }
        __syncthreads();
      }
    }
    __syncthreads();
    for (int i = 0; i < 8; ++i) {
      const int q = wave * 8 + i, tq = q0 + q, tb = tq >> 6;
      float sc0, sc1;
      {
        int n = lane;
        bool forced = (n == 0) || (n == tb) || (n == tb - 1);
        sc0 = forced ? 1e9f : ((n * 64 <= tq) ? imp[q * 129 + n] : -1e30f);
        n = lane + 64;
        forced = (n == tb) || (n == tb - 1);
        sc1 = forced ? 1e9f : ((n * 64 <= tq) ? imp[q * 129 + n] : -1e30f);
      }
      scr[wave * 128 + lane] = sc0; scr[wave * 128 + 64 + lane] = sc1;
      __syncthreads();
      int rk0 = 0, rk1 = 0;
      for (int mI = 0; mI < 128; ++mI) {
        float v = scr[wave * 128 + mI];
        rk0 += (v > sc0) || (v == sc0 && mI < lane);
        rk1 += (v > sc1) || (v == sc1 && mI < lane + 64);
      }
      u64 w0 = __ballot(rk0 < 16), w1 = __ballot(rk1 < 16);
      if (lane == 0) {
        u64* sm = (u64*)(ws + O_SELM) + ((size_t)bg * 8192 + tq) * 2;
        sm[0] = w0; sm[1] = w1;
      }
      __syncthreads();
    }
  }
}

__device__ __forceinline__ void phase_attn0(const Params& p, unsigned char* smem) {
  unsigned char* ws = p.ws;
  const int tid = TIDX, lane = tid & 63, wave = tid >> 6, l31 = lane & 31, hh = lane >> 5;
  float* lut = (float*)(smem + LUT_OFF);
#pragma unroll 1
  SNAKE_LOOP(it, 1024) {
    const int qt = 63 - (it >> 4), sub = it & 15;
    const int q0 = qt * 128, t = q0 + wave * 32 + l31, tmin = q0 + wave * 32;
    {
      const int b = sub >> 3, head = sub & 7, g = head >> 2, bg = b * 2 + g;
      __syncthreads();
      build_lut(p, lut, head);
      __syncthreads();
      bf16x8 qf[8];
      load_q((const bf16_t*)(ws + O_QN) + ((size_t)(b * 8 + head) * 8192 + t) * 128, hh, qf);
      const float* gt = (const float*)(ws + O_GATES) + (size_t)(b * 8192 + t) * 24 + head * 3;
      float* oc = (float*)(ws + O_OC) + (size_t)(b * 8192 + t) * 1024 + head * 128;
      const float scale = 0.08838834764831845f;
      f32x16 o[4]; float m_run, l_run;
      {
        int lo = q0 - 511; if (lo < 0) lo = 0;
        flash_loop<128, 1>((const bf16_t*)(ws + O_KWIN) + (size_t)bg * 8192 * 128, (const bf16_t*)(ws + O_VWINT) + (size_t)bg * 128 * 8192, 8192,
                           lo >> 6, (q0 >> 6) + 2, qf, nullptr, t, tmin, scale, lut, 0, 0, nullptr, smem, o, m_run, l_run);
        const float gw = gt[2] * (l_run > 0.f ? 1.f / l_run : 0.f);
#pragma unroll
        for (int dt = 0; dt < 4; ++dt)
#pragma unroll
          for (int rq = 0; rq < 4; ++rq) {
            float4* pp = (float4*)(oc + dt * 32 + 8 * rq + 4 * hh);
            float4 v = *pp;
            v.x += o[dt][rq * 4] * gw; v.y += o[dt][rq * 4 + 1] * gw; v.z += o[dt][rq * 4 + 2] * gw; v.w += o[dt][rq * 4 + 3] * gw;
            *pp = v;
          }
      }
    }
  }
#pragma unroll 1
  SNAKE_LOOP(it, 1024) {
    const int qt = 63 - (it >> 4), sub = it & 15;
    const int q0 = qt * 128, t = q0 + wave * 32 + l31, tmin = q0 + wave * 32;
    {
      const int b = sub >> 3, head = sub & 7, g = head >> 2, bg = b * 2 + g;
      __syncthreads();
      build_lut(p, lut, head);
      __syncthreads();
      bf16x8 qf[8];
      load_q((const bf16_t*)(ws + O_QN) + ((size_t)(b * 8 + head) * 8192 + t) * 128, hh, qf);
      const float* gt = (const float*)(ws + O_GATES) + (size_t)(b * 8192 + t) * 24 + head * 3;
      const float* oc = (const float*)(ws + O_OC) + (size_t)(b * 8192 + t) * 1024 + head * 128;
      const float scale = 0.08838834764831845f;
      f32x16 o[4]; float m_run, l_run;
      {
        const u64* sm = (const u64*)(ws + O_SELM) + ((size_t)bg * 8192 + t) * 2;
        const u64 s0 = sm[0], s1 = sm[1];
        flash_loop<128, 2>((const bf16_t*)(ws + O_KSLC) + (size_t)bg * 8192 * 128, (const bf16_t*)(ws + O_VSLCT) + (size_t)bg * 128 * 8192, 8192,
                           0, (q0 >> 6) + 2, qf, nullptr, t, tmin, scale, lut, s0, s1, nullptr, smem, o, m_run, l_run);
        const float gs = gt[1] * (l_run > 0.f ? 1.f / l_run : 0.f);
        bf16_t* at = (bf16_t*)(ws + O_ATT0) + (size_t)(b * 8192 + t) * 2048 + head * 128;
#pragma unroll
        for (int dt = 0; dt < 4; ++dt)
#pragma unroll
          for (int rq = 0; rq < 4; ++rq) {
            float4 v = *(const float4*)(oc + dt * 32 + 8 * rq + 4 * hh);
            v.x += o[dt][rq * 4] * gs; v.y += o[dt][rq * 4 + 1] * gs; v.z += o[dt][rq * 4 + 2] * gs; v.w += o[dt][rq * 4 + 3] * gs;
            *(uint2*)(at + dt * 32 + 8 * rq + 4 * hh) = make_uint2(pack2(v.x, v.y), pack2(v.z, v.w));
          }
      }
    }
  }
#pragma unroll 1
  SNAKE_LOOP(it, 1024) {
    const int qt = 63 - (it >> 4), sub = it & 15;
    const int q0 = qt * 128, t = q0 + wave * 32 + l31, tmin = q0 + wave * 32;
    {
      const int s2 = sub, b = s2 >> 3, head = s2 & 7;
      bf16x8 qf[8];
      load_q((const bf16_t*)(ws + O_QMLA) + ((size_t)(b * 8 + head) * 8192 + t) * 192, hh, qf);
      bf16_t* Qsb = (bf16_t*)(smem + LUT_OFF);
      __syncthreads();
#pragma unroll
      for (int i = 0; i < 4; ++i) {
        int c = tid + i * 256, row = c >> 3, cc = c & 7;
        *(u32x4*)(Qsb + row * 72 + cc * 8) = *(const u32x4*)((const bf16_t*)(ws + O_QMLA) + ((size_t)(b * 8 + head) * 8192 + q0 + row) * 192 + 128 + cc * 8);
      }
      const bf16_t* Qs = Qsb + (wave * 32 + l31) * 72;
      f32x16 o[4]; float m_run, l_run;
      flash_loop<192, 0>((const bf16_t*)(ws + O_KMLA) + (size_t)(b * 8 + head) * 8192 * 192, (const bf16_t*)(ws + O_VMLAT) + (size_t)(b * 8 + head) * 128 * 8192, 8192,
                         0, (q0 >> 6) + 2, qf, Qs, t, tmin, 0.07216878364870322f, nullptr, 0, 0, nullptr, smem, o, m_run, l_run);
      const float il = l_run > 0.f ? 1.f / l_run : 0.f;
      bf16_t* at = (bf16_t*)(ws + O_ATT0) + (size_t)(b * 8192 + t) * 2048 + 1024 + head * 128;
#pragma unroll
      for (int dt = 0; dt < 4; ++dt)
#pragma unroll
        for (int rq = 0; rq < 4; ++rq)
          *(uint2*)(at + dt * 32 + 8 * rq + 4 * hh) = make_uint2(pack2(o[dt][rq * 4] * il, o[dt][rq * 4 + 1] * il), pack2(o[dt][rq * 4 + 2] * il, o[dt][rq * 4 + 3] * il));
    }
  }
}

__device__ __forceinline__ unsigned okey(float f) {
  unsigned u = __float_as_uint(f);
  return (u & 0x80000000u) ? ~u : (u | 0x80000000u);
}

__device__ __forceinline__ void phase_indexer(const Params& p, unsigned char* smem) {
  unsigned char* ws = p.ws;
  const int tid = TIDX, lane = tid & 63, wave = tid >> 6, l31 = lane & 31, hh = lane >> 5;
  _Float16* IQs = (_Float16*)smem;
  const _Float16* IQ = (const _Float16*)(ws + O_IQ);
  const _Float16* IK = (const _Float16*)(ws + O_IK);
  const float* IW = (const float*)(ws + O_IW);
  SNAKE_LOOP(it, 1024) {
    const int qt = 255 - (it >> 2), b = (it >> 1) & 1, kh = it & 1;
    const int q0 = qt * 32;
    float* scb = (float*)(ws + O_SC) + (size_t)b * SC_PERB + 1024ull * ((size_t)qt * (qt + 1) / 2);
    const int stride = 32 * (qt + 1);
    __syncthreads();
#pragma unroll
    for (int i = 0; i < 16; ++i) {
      int c = tid + i * 256, q = c >> 7, cc = c & 127;
      *(u32x4*)(IQs + q * 1032 + cc * 8) = *(const u32x4*)(IQ + ((size_t)(b * 8192 + q0 + q) * 1024 + cc * 8));
    }
    float* IWs = (float*)(smem + 66048);
    for (int e = tid; e < 512; e += 256) IWs[e] = IW[(size_t)(b * 8192 + q0) * 16 + e];
    __syncthreads();
    const int npairs = (qt + 2) >> 1;
    for (int pi = 2 * wave + kh; pi < npairs; pi += 8) {
      const int kb0 = 2 * pi, kb1 = 2 * pi + 1;
      f16x8 a0[4], a1[4];
#pragma unroll
      for (int ks = 0; ks < 4; ++ks) {
        a0[ks] = *(const f16x8*)(IK + ((size_t)(b * 8192 + kb0 * 32 + l31) * 64 + ks * 16 + hh * 8));
        a1[ks] = *(const f16x8*)(IK + ((size_t)(b * 8192 + kb1 * 32 + l31) * 64 + ks * 16 + hh * 8));
      }
      f32x16 tot0, tot1;
#pragma unroll
      for (int r = 0; r < 16; ++r) { tot0[r] = 0.f; tot1[r] = 0.f; }
#pragma unroll 1
      for (int hd = 0; hd < 16; ++hd) {
        f32x16 s0, s1;
#pragma unroll
        for (int r = 0; r < 16; ++r) { s0[r] = 0.f; s1[r] = 0.f; }
#pragma unroll
        for (int ks = 0; ks < 4; ++ks) {
          f16x8 bq = *(const f16x8*)(IQs + l31 * 1032 + hd * 64 + ks * 16 + hh * 8);
          s0 = MFMA_F16(a0[ks], bq, s0);
          s1 = MFMA_F16(a1[ks], bq, s1);
        }
        const float w = IWs[l31 * 16 + hd];
#pragma unroll
        for (int r = 0; r < 16; ++r) { tot0[r] += w * fmaxf(s0[r], 0.f); tot1[r] += w * fmaxf(s1[r], 0.f); }
      }
      float* rowp = scb + (size_t)l31 * stride;
#pragma unroll
      for (int rq = 0; rq < 4; ++rq) {
        *(float4*)(rowp + kb0 * 32 + 8 * rq + 4 * hh) = make_float4(tot0[rq * 4] + 0.f, tot0[rq * 4 + 1] + 0.f, tot0[rq * 4 + 2] + 0.f, tot0[rq * 4 + 3] + 0.f);
      }
      if (kb1 <= qt) {
#pragma unroll
        for (int rq = 0; rq < 4; ++rq) {
          *(float4*)(rowp + kb1 * 32 + 8 * rq + 4 * hh) = make_float4(tot1[rq * 4] + 0.f, tot1[rq * 4 + 1] + 0.f, tot1[rq * 4 + 2] + 0.f, tot1[rq * 4 + 3] + 0.f);
        }
      }
    }
  }
}

__device__ __forceinline__ void phase_select(const Params& p, unsigned char* smem) {
  unsigned char* ws = p.ws;
  const int tid = TIDX, lane = tid & 63, wave = tid >> 6;
  unsigned* hist = (unsigned*)smem + wave * 2112;
  unsigned* kl = (unsigned*)(smem + 36864) + wave * 1024 + lane;
#define KEY(w) ((w) < 16 ? kl[(w) * 64] : key[(w) - 16])
#pragma unroll 1
  SNAKE_LOOP(idx4, 4096) {
    const int idx = idx4 * 4 + wave;
    const int t = 8191 - (idx >> 1), b = idx & 1;
    const int qt = t >> 5, q = t & 31;
    const float* rowp = (const float*)(ws + O_SC) + (size_t)b * SC_PERB + 1024ull * ((size_t)qt * (qt + 1) / 2) + (size_t)q * (32 * (qt + 1));
    unsigned key[112];
#pragma unroll
    for (int w = 0; w < 128; ++w) {
      const int s = w * 64 + lane;
      const int scl = min(s, t);
      const unsigned kk = okey(rowp[scl]);
      const unsigned vm = 0u - (unsigned)min(max(t + 1 - s, 0), 1);
      if (w < 16) kl[w * 64] = kk & vm; else key[w - 16] = kk & vm;
    }
    asm volatile("s_waitcnt lgkmcnt(0)" ::: "memory");
    unsigned T = 0; int need = 0, eqc = 0;
    if (t + 1 > 256) {
      unsigned prefix = 0; int krem = 256;
#pragma unroll 1
      for (int pass = 0; pass < 3; ++pass) {
        const int shift = pass == 0 ? 21 : (pass == 1 ? 10 : 0);
        const int nbits = pass == 2 ? 10 : 11;
        const unsigned dmask = (1u << nbits) - 1u;
        unsigned klo = 1u, khi = 0xFFFFFFFFu;
        if (pass > 0) { klo = prefix << (shift + nbits); khi = klo | ((1u << (shift + nbits)) - 1u); if (klo == 0u) klo = 1u; }
        const unsigned span = khi - klo;
#pragma unroll
        for (int e = 0; e < 32; ++e) hist[e * 64 + lane] = 0;
        asm volatile("s_waitcnt lgkmcnt(0)" ::: "memory");
#pragma unroll
        for (int w = 0; w < 128; ++w) {
          const unsigned k = KEY(w);
          const unsigned d = k - klo;
          const unsigned nz = min(d - min(d, span), 1u);
          const unsigned fk = (k >> shift) & dmask;
          const unsigned bin = fk + nz * (2048u + (unsigned)lane - fk);
          atomicAdd(&hist[bin], 1u);
        }
        asm volatile("s_waitcnt lgkmcnt(0)" ::: "memory");
        unsigned local = 0;
#pragma unroll
        for (int j = 0; j < 32; ++j) local += hist[lane * 32 + j];
        unsigned incl = local;
#pragma unroll
        for (int o = 1; o < 64; o <<= 1) { unsigned v = __shfl_down(incl, o); if (lane + o < 64) incl += v; }
        const unsigned above = incl - local;
        const bool mine = ((int)above < krem) && ((int)(above + local) >= krem);
        unsigned dig = 0, kr = 0, hc = 0;
        if (mine) {
          unsigned acc = above; bool done = false;
#pragma unroll 1
          for (int j = 31; j >= 0; --j) {
            const unsigned h = hist[lane * 32 + j];
            if (!done && (int)(acc + h) >= krem) { dig = (unsigned)(lane * 32 + j); kr = (unsigned)(krem - (int)acc); hc = h; done = true; }
            acc += h;
          }
        }
        const int src = __ffsll((unsigned long long)__ballot(mine)) - 1;
        dig = (unsigned)__shfl((int)dig, src); kr = (unsigned)__shfl((int)kr, src); hc = (unsigned)__shfl((int)hc, src);
        prefix = (prefix << nbits) | dig;
        krem = (int)kr; eqc = (int)hc;
        asm volatile("s_waitcnt lgkmcnt(0)" ::: "memory");
      }
      T = prefix; need = krem;
    }
    u64* bm = (u64*)(ws + O_BITM) + (size_t)(b * 8192 + t) * 128;
    if (need == eqc) {
      unsigned v0lo = 0, v0hi = 0, v1lo = 0, v1hi = 0;
#pragma unroll
      for (int w = 0; w < 128; ++w) {
        const unsigned kw = KEY(w);
        const u64 word = __ballot(kw >= T && kw != 0u);
        const unsigned wl = (unsigned)word, wh = (unsigned)(word >> 32);
        if (w < 64) {
          asm volatile("s_nop 1\n\tv_writelane_b32 %0, %1, %2" : "+v"(v0lo) : "s"(wl), "n"(w & 63));
          asm volatile("v_writelane_b32 %0, %1, %2" : "+v"(v0hi) : "s"(wh), "n"(w & 63));
        } else {
          asm volatile("s_nop 1\n\tv_writelane_b32 %0, %1, %2" : "+v"(v1lo) : "s"(wl), "n"(w & 63));
          asm volatile("v_writelane_b32 %0, %1, %2" : "+v"(v1hi) : "s"(wh), "n"(w & 63));
        }
      }
      bm[lane] = ((u64)v0hi << 32) | v0lo; bm[64 + lane] = ((u64)v1hi << 32) | v1lo;
    } else {
      int base = 0;
#pragma unroll 1
      for (int w = 0; w < 128; ++w) {
        const int s = w * 64 + lane;
        unsigned k = 0;
        if (s <= t) k = okey(rowp[s]);
        const bool gt = (s <= t) && k > T;
        const bool eq = (s <= t) && k == T;
        const u64 eqm = __ballot(eq);
        const int rank = base + (int)__builtin_amdgcn_mbcnt_hi((unsigned)(eqm >> 32), __builtin_amdgcn_mbcnt_lo((unsigned)eqm, 0u));
        const u64 word = __ballot(gt || (eq && rank < need));
        base += __popcll(eqm);
        if (lane == 0) bm[w] = word;
      }
    }
  }
}

#undef KEY
__device__ __forceinline__ void phase_dsa_attn(const Params& p, unsigned char* smem) {
  unsigned char* ws = p.ws;
  const int tid = TIDX, lane = tid & 63, wave = tid >> 6, l31 = lane & 31, hh = lane >> 5;
  float* lut = (float*)(smem + LUT_OFF);
  SNAKE_LOOP(it, 2048) {
    const int qt = 63 - (it >> 5), sub = it & 31, b = sub >> 4, head = sub & 15, kvh = head >> 2;
    const int q0 = qt * 128, t = q0 + wave * 32 + l31, tmin = q0 + wave * 32;
    __syncthreads();
    build_lut(p, lut, head);
    __syncthreads();
    bf16x8 qf[8];
    load_q((const bf16_t*)(ws + O_QD) + ((size_t)(b * 16 + head) * 8192 + t) * 128, hh, qf);
    f32x16 o[4]; float m_run, l_run;
    flash_loop<128, 3>((const bf16_t*)(ws + O_KD) + (size_t)(b * 4 + kvh) * 8192 * 128, (const bf16_t*)(ws + O_VDT) + (size_t)(b * 4 + kvh) * 128 * 8192, 8192,
                       0, (q0 >> 6) + 2, qf, nullptr, t, tmin, 0.08838834764831845f, lut, 0, 0, (const u64*)(ws + O_BITM) + (size_t)(b * 8192 + t) * 128, smem, o, m_run, l_run);
    const float il = l_run > 0.f ? 1.f / l_run : 0.f;
    bf16_t* at = (bf16_t*)(ws + O_ATT1) + (size_t)(b * 8192 + t) * 2048 + head * 128;
#pragma unroll
    for (int dt = 0; dt < 4; ++dt)
#pragma unroll
      for (int rq = 0; rq < 4; ++rq)
        *(uint2*)(at + dt * 32 + 8 * rq + 4 * hh) = make_uint2(pack2(o[dt][rq * 4] * il, o[dt][rq * 4 + 1] * il), pack2(o[dt][rq * 4 + 2] * il, o[dt][rq * 4 + 3] * il));
  }
}

#define XB_TMO      128
#define XB_XCNT(j)  (256  + 64 * (j))
#define XB_XSUB(j)  (1280 + 64 * (j))
#define XB_XGEN(j)  (2304 + 64 * (j))
#define XB_TOP      3328
#define XB_TOPGEN   3392
#define XCD_BAR_WORDS 3456
#define XB_SPIN_CAP (1u << 25)
#define LAS __attribute__((address_space(3)))

__device__ __forceinline__ unsigned xb_ld(unsigned* p)              { return __hip_atomic_load(p, __ATOMIC_RELAXED, __HIP_MEMORY_SCOPE_AGENT); }
__device__ __forceinline__ unsigned xb_add(unsigned* p, unsigned v) { return __hip_atomic_fetch_add(p, v, __ATOMIC_RELAXED, __HIP_MEMORY_SCOPE_AGENT); }
__device__ __forceinline__ unsigned xb_xcc_id() { return (unsigned)__builtin_amdgcn_s_getreg((3 << 11) | 20) & 0xFu; }
#define XB_SPIN(cond, bar) do { unsigned _sp = 0; while (cond) { __builtin_amdgcn_s_sleep(1); \
    if ((++_sp & 255u) == 0u) { if (xb_ld(&(bar)[XB_TMO])) break; if (_sp > XB_SPIN_CAP) { atomicAdd(&(bar)[XB_TMO], 1u); break; } } } } while (0)

struct XcdBarrier {
    unsigned* bar; unsigned x;
    volatile LAS unsigned* st;
};

__device__ __forceinline__ XcdBarrier xcd_barrier_post(unsigned* bar, volatile LAS unsigned* st) {
    XcdBarrier b; b.bar = bar; b.x = xb_xcc_id(); b.st = st;
    if (TIDX == 0) (void)xb_add(&bar[XB_XCNT(b.x)], 1u);
    return b;
}
__device__ __forceinline__ void xcd_barrier_complete(unsigned* bar, unsigned x, unsigned& nloc, unsigned& nx) {
    const unsigned G = gridDim.x * gridDim.y * gridDim.z;
    unsigned sum, cnt, mine, sp = 0u;
    for (;;) {
        sum = 0u; cnt = 0u; mine = 0u;
#pragma unroll
        for (unsigned j = 0; j < 16; ++j) { const unsigned c = xb_ld(&bar[XB_XCNT(j)]); sum += c; cnt += (c > 0u) ? 1u : 0u; mine = (j == x) ? c : mine; }
        if (sum == G) break;
        __builtin_amdgcn_s_sleep(1);
        if ((++sp & 255u) == 0u) { if (xb_ld(&bar[XB_TMO])) break; if (sp > XB_SPIN_CAP) { atomicAdd(&bar[XB_TMO], 1u); break; } }
    }
    nloc = mine > 0u ? mine : 1u; nx = cnt > 0u ? cnt : 1u;
}

__device__ __forceinline__ void xcd_barrier(const XcdBarrier& b) {
    asm volatile("s_waitcnt vmcnt(0)" ::: "memory");
    __syncthreads();
    if (TIDX == 0) {
        unsigned* bar = b.bar;
        const unsigned bx = xb_xcc_id();
        __builtin_amdgcn_s_waitcnt(0);
        unsigned nloc = b.st[0], nx = b.st[1];
        if (nloc == 0u) { xcd_barrier_complete(bar, bx, nloc, nx); b.st[0] = nloc; b.st[1] = nx; }
        const unsigned old = xb_add(&bar[XB_XSUB(bx)], 1u);
        const unsigned gen = old / nloc;
        if (old + 1u == (gen + 1u) * nloc) {
            __builtin_amdgcn_fence(__ATOMIC_RELEASE, "agent");
            asm volatile("s_waitcnt vmcnt(0)" ::: "memory");
            const unsigned og = xb_add(&bar[XB_TOP], 1u);
            const unsigned tg = og / nx;
            if (og + 1u == (tg + 1u) * nx) xb_add(&bar[XB_TOPGEN], 1u);
            else XB_SPIN(xb_ld(&bar[XB_TOPGEN]) == tg, bar);
            __builtin_amdgcn_fence(__ATOMIC_ACQUIRE, "agent");
            xb_add(&bar[XB_XGEN(bx)], 1u);
            asm volatile("s_waitcnt vmcnt(0)" ::: "memory");
        } else {
            XB_SPIN(xb_ld(&bar[XB_XGEN(bx)]) == gen, bar);
            __builtin_amdgcn_fence(__ATOMIC_ACQUIRE, "agent");
            asm volatile("s_waitcnt vmcnt(0)" ::: "memory");
        }
    }
    __syncthreads();
}


#define NPHASES 20
#ifndef ONLY_PHASE
#define ONLY_PHASE -1
#endif
#define PH(n) (ONLY_PHASE < 0 || ONLY_PHASE == (n))
typedef const Params __attribute__((address_space(4))) * KParamsP;
__device__ __forceinline__ void get_params(Params& lp) {
  KParamsP pp = (KParamsP)__builtin_amdgcn_kernarg_segment_ptr();
  asm volatile("" : "+s"(pp));
#pragma unroll
  for (int i = 0; i < 27; ++i) lp.in[i] = pp->in[i];
  lp.out = pp->out; lp.ws = pp->ws; lp.ph_lo = 0; lp.ph_hi = 0;
}
#ifndef REPEAT_MASK
#define REPEAT_MASK 0
#endif
#define RUNPH(n, call) if (PH(n)) { Params p; get_params(p); unsigned char* ws = p.ws; (void)ws; call; if ((REPEAT_MASK >> (n)) & 1) { grid.sync(); call; } }

__global__ void __launch_bounds__(256, 2) mega(Params p_unused) {
  __shared__ __attribute__((aligned(16))) unsigned char smem[SMEM_BYTES];
  cg::grid_group grid = cg::this_grid();
  __shared__ uint4 xb_words;
  if (TIDX == 0) xb_words = make_uint4(0u, 0u, 0u, 0u);
  __syncthreads();
  XcdBarrier xb;
  { Params p; get_params(p); xb = xcd_barrier_post((unsigned*)(p.ws + O_BAR), (volatile LAS unsigned*)&xb_words); }
  RUNPH(0, phase_prep(p, smem))
  grid.sync();
  RUNPH(1, phase_reduce(p))
  xcd_barrier(xb);
#pragma unroll 1
  for (int L = 0; L < 2; ++L) {
    RUNPH(2, phase_norm(p, L == 0 ? p.in[I_X] : p.out, 2 * L))
    xcd_barrier(xb);
    if (L == 0) {
      RUNPH(3, phase_evin(p, smem))
      xcd_barrier(xb);
      RUNPH(4, phase_mid(p, smem))
      xcd_barrier(xb);
      RUNPH(5, phase_cmp2(p, smem))
      xcd_barrier(xb);
      RUNPH(6, phase_cmp_attn(p, smem))
      xcd_barrier(xb);
      RUNPH(7, phase_attn0(p, smem))
      xcd_barrier(xb);
    } else {
      RUNPH(13, phase_odin(p, smem))
      xcd_barrier(xb);
      RUNPH(14, phase_indexer(p, smem))
      xcd_barrier(xb);
      RUNPH(16, phase_select(p, smem))
      xcd_barrier(xb);
      RUNPH(15, phase_dsa_attn(p, smem))
      xcd_barrier(xb);
    }
    RUNPH(8, phase_resid(p, (const bf16_t*)(ws + (L == 0 ? O_ATT0 : O_ATT1)), 2048, (const bf16_t*)(ws + (L == 0 ? O_WEVOUT : O_WODOUT)),
                         L == 0 ? p.in[I_X] : p.out, p.out, 2 * L, smem))
    xcd_barrier(xb);
    RUNPH(2, phase_norm(p, p.out, 2 * L + 1))
    xcd_barrier(xb);
    RUNPH(10, phase_ffn_up(p, L, smem))
    xcd_barrier(xb);
    RUNPH(8, phase_resid(p, (const bf16_t*)(ws + O_ACT), 4096, (const bf16_t*)(ws + O_WDOWN) + (size_t)L * 2048 * 4096, p.out, p.out, 2 * L + 1, smem))
    if (L == 0) xcd_barrier(xb);
  }
}

extern "C" void kernel_launch(void* const* d_in, const int* in_sizes, int n_in, void* d_out, int out_size, void* d_ws, size_t ws_size,
                              hipStream_t stream) {
  static int grid_blocks = 0;
  if (!grid_blocks) {
    int dev = 0, cus = 0, per_cu = 0;
    hipGetDevice(&dev);
    hipDeviceGetAttribute(&cus, hipDeviceAttributeMultiprocessorCount, dev);
    hipOccupancyMaxActiveBlocksPerMultiprocessor(&per_cu, mega, 256, 0);
    if (per_cu < 1) per_cu = 1;
    if (per_cu > 2) per_cu = 2;
    grid_blocks = cus * per_cu;
    if (n_in != 27 || ws_size < WS_NEED) {
      fprintf(stderr, "kernel_launch: need %zu bytes of workspace, got %zu (n_in %d)\n", (size_t)WS_NEED, ws_size, n_in);
      grid_blocks = -1;
    }
  }
  if (grid_blocks < 0) return;
  (void)hipMemsetAsync((unsigned char*)d_ws + O_BAR, 0, XCD_BAR_WORDS * sizeof(unsigned), stream);
  Params p{};
  for (int i = 0; i < 27; ++i) p.in[i] = (const float*)d_in[i];
  p.out = (float*)d_out;
  p.ws = (unsigned char*)d_ws;
  p.ph_lo = 0; p.ph_hi = NPHASES;
  void* args[] = {&p};
  hipError_t e = hipLaunchCooperativeKernel((void*)mega, dim3(grid_blocks), dim3(256), args, 0, stream);
  if (e != hipSuccess) fprintf(stderr, "cooperative launch failed: %s (grid %d)\n", hipGetErrorString(e), grid_blocks);
}
```

```cpp
#include <hip/hip_runtime.h>
#include <hip/hip_cooperative_groups.h>
#include <stdint.h>
#include <stdio.h>
namespace cg = cooperative_groups;

typedef unsigned short bf16_t;
typedef unsigned long long u64;
typedef __attribute__((ext_vector_type(8))) short bf16x8;
typedef __attribute__((ext_vector_type(8))) _Float16 f16x8;
typedef __attribute__((ext_vector_type(16))) float f32x16;
typedef __attribute__((ext_vector_type(4))) unsigned u32x4;
typedef __attribute__((ext_vector_type(2))) unsigned u32x2;
typedef __attribute__((ext_vector_type(4))) float f32x4;
typedef __attribute__((ext_vector_type(4))) short s16x4;

#define SEQ 8192
#define NTOK 16384
#define DM 2048
#define EPSF 1e-6f
#define NEG_INF (-__builtin_inff())

constexpr size_t AL(size_t x) { return (x + 255) & ~size_t(255); }
constexpr size_t O_WEVIN  = 0;
constexpr size_t O_WEVOUT = O_WEVIN  + AL(3456ull * 2048 * 2);
constexpr size_t O_WCW1   = O_WEVOUT + AL(2048ull * 2048 * 2);
constexpr size_t O_WCW2   = O_WCW1   + AL(2ull * 256 * 4096 * 2);
constexpr size_t O_WUQ    = O_WCW2   + AL(2ull * 128 * 256 * 2);
constexpr size_t O_WUKV   = O_WUQ    + AL(1536ull * 512 * 2);
constexpr size_t O_WODIN  = O_WUKV   + AL(2048ull * 256 * 2);
constexpr size_t O_WODOUT = O_WODIN  + AL(4224ull * 2048 * 2);
constexpr size_t O_WUP    = O_WODOUT + AL(2048ull * 2048 * 2);
constexpr size_t O_WDOWN  = O_WUP    + AL(2ull * 8192 * 2048 * 2);
constexpr size_t O_ADAP   = O_WDOWN  + AL(2ull * 2048 * 4096 * 2);
constexpr size_t O_ADAM   = O_ADAP   + AL(4ull * 32 * 2 * 6144 * 4);
constexpr size_t O_CB1PART= O_ADAM   + AL(4ull * 2 * 6144 * 4);
constexpr size_t O_CB1P   = O_CB1PART+ AL(2ull * 16 * 256 * 4);
constexpr size_t O_ROPE64 = O_CB1P   + AL(2ull * 256 * 4);
constexpr size_t O_ROPE32 = O_ROPE64 + AL(2ull * 8192 * 32 * 4);
constexpr size_t O_H      = O_ROPE32 + AL(2ull * 8192 * 16 * 4);
constexpr size_t O_REG    = O_H      + AL(16384ull * 2048 * 2);
constexpr size_t O_QN     = O_REG;
constexpr size_t O_KSLC   = O_QN     + AL(16384ull * 1024 * 2);
constexpr size_t O_KWIN   = O_KSLC   + AL(16384ull * 256 * 2);
constexpr size_t O_VSLCT  = O_KWIN   + AL(16384ull * 256 * 2);
constexpr size_t O_VWINT  = O_VSLCT  + AL(16384ull * 256 * 2);
constexpr size_t O_KVSRC  = O_VWINT  + AL(16384ull * 256 * 2);
constexpr size_t O_HID    = O_KVSRC  + AL(8ull * 8192 * 128 * 2 + 65536);
constexpr size_t O_KCMP   = O_HID    + AL(8ull * 512 * 256 * 2);
constexpr size_t O_VCMPT  = O_KCMP   + AL(4ull * 512 * 128 * 2);
constexpr size_t O_CQ     = O_VCMPT  + AL(4ull * 512 * 128 * 2);
constexpr size_t O_CKV    = O_CQ     + AL(16384ull * 512 * 2);
constexpr size_t O_SSQ    = O_CKV    + AL(16384ull * 256 * 2);
constexpr size_t O_GATES  = O_SSQ    + AL(16384ull * 8 * 4);
constexpr size_t O_QMLA   = O_GATES  + AL(16384ull * 24 * 4);
constexpr size_t O_KMLA   = O_QMLA   + AL(16384ull * 8 * 192 * 2);
constexpr size_t O_VMLAT  = O_KMLA   + AL(16384ull * 8 * 192 * 2);
constexpr size_t O_OC     = O_VMLAT  + AL(16384ull * 1024 * 2);
constexpr size_t O_SELM   = O_OC     + AL(16384ull * 1024 * 4);
constexpr size_t O_ATT0   = O_SELM   + AL(4ull * 8192 * 16);
constexpr size_t O_L0END  = O_ATT0   + AL(16384ull * 2048 * 2);
constexpr size_t O_QD     = O_REG;
constexpr size_t O_KD     = O_QD     + AL(16384ull * 2048 * 2);
constexpr size_t O_VDT    = O_KD     + AL(16384ull * 512 * 2);
constexpr size_t O_IQ     = O_VDT    + AL(16384ull * 512 * 2);
constexpr size_t O_IK     = O_IQ     + AL(16384ull * 1024 * 2);
constexpr size_t O_IW     = O_IK     + AL(16384ull * 64 * 2 + 65536);
constexpr size_t O_BITM   = O_IW     + AL(16384ull * 16 * 4);
constexpr size_t O_SC     = O_BITM   + AL(16384ull * 128 * 8);
constexpr size_t SC_PERB  = 1024ull * (256ull * 257 / 2);
constexpr size_t O_ATT1   = O_SC;
constexpr size_t O_L1END  = O_SC     + AL(2ull * SC_PERB * 4);
constexpr size_t O_ACT    = O_REG;
constexpr size_t O_ACTEND = O_ACT    + AL(16384ull * 4096 * 2);
constexpr size_t cmax(size_t a, size_t b) { return a > b ? a : b; }
constexpr size_t O_BAR    = cmax(cmax(O_L0END, O_L1END), O_ACTEND);
constexpr size_t WS_NEED  = O_BAR + 16384;

struct Params {
  const float* in[27];
  float* out;
  unsigned char* ws;
  int ph_lo, ph_hi;
};
enum { I_X = 0, I_C, I_REL, I_ADAW, I_ADAB, I_NORMG, I_EVIN, I_EVOUT, I_NSAG, I_CPE, I_CW1, I_CB1, I_CW2, I_CB2,
       I_MQG, I_MKVG, I_WUQ, I_WUKV, I_NOPEG, I_ROPEG, I_ODIN, I_ODOUT, I_DSAG, I_FUP, I_FCW, I_FCB, I_FDOWN };

#define SMEM_BYTES 68608

__device__ __forceinline__ int tidx_() { int t = threadIdx.x; asm volatile("" : "+v"(t)); return t; }
#define TIDX tidx_()
#define SNAKE_LOOP(it, n) for (int _r = 0, it = blockIdx.x; _r * (int)gridDim.x < (n); ++_r, it = _r * gridDim.x + ((_r & 1) ? (gridDim.x - 1 - blockIdx.x) : blockIdx.x)) if (it < (n))
__device__ __forceinline__ unsigned short f2bf(float f) {
  unsigned u = __float_as_uint(f);
  u += 0x7fffu + ((u >> 16) & 1u);
  return (unsigned short)(u >> 16);
}
typedef __attribute__((ext_vector_type(2))) float f32x2_t;
typedef __attribute__((ext_vector_type(2))) __bf16 bf16x2_t;
__device__ __forceinline__ unsigned pack2(float a, float b) {
  f32x2_t v = {a, b};
  bf16x2_t r = __builtin_convertvector(v, bf16x2_t);
  return __builtin_bit_cast(unsigned, r);
}
#define EXP2F(x) __builtin_amdgcn_exp2f(x)
__device__ __forceinline__ float xmax32(float v) {
  auto r = __builtin_amdgcn_permlane32_swap(__float_as_uint(v), __float_as_uint(v), false, false);
  return fmaxf(__uint_as_float(r[0]), __uint_as_float(r[1]));
}
__device__ __forceinline__ float xsum32(float v) {
  auto r = __builtin_amdgcn_permlane32_swap(__float_as_uint(v), __float_as_uint(v), false, false);
  return __uint_as_float(r[0]) + __uint_as_float(r[1]);
}
#define LOG2E 1.4426950408889634f
__device__ __forceinline__ float dpp_row_sum(float v) {
  v += __uint_as_float(__builtin_amdgcn_update_dpp(0u, __float_as_uint(v), 0xB1, 0xF, 0xF, true));
  v += __uint_as_float(__builtin_amdgcn_update_dpp(0u, __float_as_uint(v), 0x4E, 0xF, 0xF, true));
  v += __uint_as_float(__builtin_amdgcn_update_dpp(0u, __float_as_uint(v), 0x141, 0xF, 0xF, true));
  v += __uint_as_float(__builtin_amdgcn_update_dpp(0u, __float_as_uint(v), 0x140, 0xF, 0xF, true));
  return v;
}
__device__ __forceinline__ float half_sum(float v) {
  v = dpp_row_sum(v);
  return v + __shfl_xor(v, 16);
}
__device__ __forceinline__ float wave_sum(float v) {
  v = half_sum(v);
  auto r = __builtin_amdgcn_permlane32_swap(__float_as_uint(v), __float_as_uint(v), false, false);
  return __uint_as_float(r[0]) + __uint_as_float(r[1]);
}
__device__ __forceinline__ float sigmoidf_(float x) { return __builtin_amdgcn_rcpf(1.f + __expf(-x)); }
__device__ __forceinline__ float siluf_(float x) { return x * __builtin_amdgcn_rcpf(1.f + __expf(-x)); }
__device__ __forceinline__ float geluf_(float x) {
  float u = 0.7978845608028654f * (x + 0.044715f * x * x * x);
  float e = __expf(2.f * u);
  float th = 1.f - 2.f * __builtin_amdgcn_rcpf(e + 1.f);
  return 0.5f * x * (1.f + th);
}
__device__ __forceinline__ int t5_bucket(int n) {
  if (n < 16) return n < 0 ? 0 : n;
  float v = logf((float)n / 16.f) / 2.0794415416798357f * 16.f;
  int l = 16 + (int)v;
  return l > 31 ? 31 : l;
}
#define MFMA_BF16(a, b, c) __builtin_amdgcn_mfma_f32_32x32x16_bf16((a), (b), (c), 0, 0, 0)
#define MFMA_F16(a, b, c) __builtin_amdgcn_mfma_f32_32x32x16_f16((a), (b), (c), 0, 0, 0)

__device__ __forceinline__ int src_col(int job, int n) {
  switch (job) {
    case 0:
      if (n < 2560) return n;
      if (n < 3072) return 2584 + (n - 2560);
      if (n < 3328) return 3096 + (n - 3072);
      if (n < 3392) return 3352 + (n - 3328);
      if (n < 3416) return 2560 + (n - 3392);
      return -1;
    case 6:
      if (n < 1024) return (n >> 7) * 192 + (n & 127);
      return ((n - 1024) >> 6) * 192 + 128 + ((n - 1024) & 63);
    case 8:
      return n < 4176 ? n : -1;
    case 10: case 11: {
      int tl = n >> 7, w = n & 127;
      return w < 64 ? tl * 64 + w : 4096 + tl * 64 + (w - 64);
    }
    default: return n;
  }
}

struct WTile { const float* src; bf16_t* dst; const float* rs; int K, N, n0, k0, c; };
__device__ __forceinline__ void decode_wtile(const Params& p, int it, WTile& w) {
  int t = it, job;
  if (t < 1728) job = 0;
  else if ((t -= 1728) < 1024) job = 1;
  else if ((t -= 1024) < 256) job = 2;
  else if ((t -= 256) < 256) job = 3;
  else if ((t -= 256) < 8) job = 4;
  else if ((t -= 8) < 8) job = 5;
  else if ((t -= 8) < 192) job = 6;
  else if ((t -= 192) < 128) job = 7;
  else if ((t -= 128) < 2112) job = 8;
  else if ((t -= 2112) < 1024) job = 9;
  else if ((t -= 1024) < 4096) job = 10;
  else if ((t -= 4096) < 4096) job = 11;
  else if ((t -= 4096) < 2048) job = 12;
  else { t -= 2048; job = 13; }
  const float* src; bf16_t* dst; int K, N, NP; const float* rs = nullptr;
  unsigned char* ws = p.ws;
  switch (job) {
    case 0: src = p.in[I_EVIN]; dst = (bf16_t*)(ws + O_WEVIN); K = 2048; N = 3416; NP = 3456; break;
    case 1: src = p.in[I_EVOUT]; dst = (bf16_t*)(ws + O_WEVOUT); K = 2048; N = 2048; NP = 2048; break;
    case 2: src = p.in[I_CW1]; dst = (bf16_t*)(ws + O_WCW1); K = 4096; N = 256; NP = 256; break;
    case 3: src = p.in[I_CW1] + 4096 * 256; dst = (bf16_t*)(ws + O_WCW1) + 256 * 4096; K = 4096; N = 256; NP = 256; break;
    case 4: src = p.in[I_CW2]; dst = (bf16_t*)(ws + O_WCW2); K = 256; N = 128; NP = 128; break;
    case 5: src = p.in[I_CW2] + 256 * 128; dst = (bf16_t*)(ws + O_WCW2) + 128 * 256; K = 256; N = 128; NP = 128; break;
    case 6: src = p.in[I_WUQ]; dst = (bf16_t*)(ws + O_WUQ); K = 512; N = 1536; NP = 1536; rs = p.in[I_MQG]; break;
    case 7: src = p.in[I_WUKV]; dst = (bf16_t*)(ws + O_WUKV); K = 256; N = 2048; NP = 2048; rs = p.in[I_MKVG]; break;
    case 8: src = p.in[I_ODIN]; dst = (bf16_t*)(ws + O_WODIN); K = 2048; N = 4176; NP = 4224; break;
    case 9: src = p.in[I_ODOUT]; dst = (bf16_t*)(ws + O_WODOUT); K = 2048; N = 2048; NP = 2048; break;
    case 10: src = p.in[I_FUP]; dst = (bf16_t*)(ws + O_WUP); K = 2048; N = 8192; NP = 8192; break;
    case 11: src = p.in[I_FUP] + 2048ull * 8192; dst = (bf16_t*)(ws + O_WUP) + 8192ull * 2048; K = 2048; N = 8192; NP = 8192; break;
    case 12: src = p.in[I_FDOWN]; dst = (bf16_t*)(ws + O_WDOWN); K = 4096; N = 2048; NP = 2048; break;
    default: src = p.in[I_FDOWN] + 4096ull * 2048; dst = (bf16_t*)(ws + O_WDOWN) + 2048ull * 4096; K = 4096; N = 2048; NP = 2048; break;
  }
  (void)NP;
  const int ktiles = K >> 6;
  w.src = src; w.dst = dst; w.rs = rs; w.K = K; w.N = N;
  w.n0 = (t / ktiles) << 6; w.k0 = (t % ktiles) << 6;
  w.c = src_col(job, w.n0 + 4 * (TIDX & 15));
}
__device__ __forceinline__ void wtile_load(const WTile& w, float4 (&v)[4]) {
  const int tid = TIDX, cc = w.c >= 0 ? w.c : 0;
#pragma unroll
  for (int i = 0; i < 4; ++i) v[i] = *(const float4*)(w.src + (size_t)(w.k0 + (tid >> 4) + 16 * i) * w.N + cc);
}
__device__ __forceinline__ void wtile_to_lds(const WTile& w, const float4 (&v)[4], float* tl) {
  const int tid = TIDX, n4 = tid & 15;
#pragma unroll
  for (int i = 0; i < 4; ++i) {
    const int k = (tid >> 4) + 16 * i;
    float sc = (w.c >= 0) ? 1.f : 0.f;
    if (w.rs) sc *= w.rs[w.k0 + k];
    tl[k * 65 + 4 * n4 + 0] = v[i].x * sc; tl[k * 65 + 4 * n4 + 1] = v[i].y * sc;
    tl[k * 65 + 4 * n4 + 2] = v[i].z * sc; tl[k * 65 + 4 * n4 + 3] = v[i].w * sc;
  }
}
__device__ __forceinline__ void wtile_store(const WTile& w, const float* tl) {
  const int tid = TIDX, n = tid >> 2, kc = tid & 3;
  unsigned x[8];
#pragma unroll
  for (int j = 0; j < 8; ++j) x[j] = pack2(tl[(kc * 16 + 2 * j) * 65 + n], tl[(kc * 16 + 2 * j + 1) * 65 + n]);
  uint4* d = (uint4*)(w.dst + (size_t)(w.n0 + n) * w.K + w.k0 + kc * 16);
  d[0] = make_uint4(x[0], x[1], x[2], x[3]);
  d[1] = make_uint4(x[4], x[5], x[6], x[7]);
}

#define NW_TILES 19024
#define NADA_ITEMS 768
#define NCB1_ITEMS 32
#define NROPE_ITEMS 1536

__device__ __forceinline__ void phase_prep(const Params& p, unsigned char* smem) {
  const int total = NW_TILES + NADA_ITEMS + NCB1_ITEMS + NROPE_ITEMS;
  const int tid = TIDX;
#pragma unroll 1
  for (int it = blockIdx.x; it < NW_TILES; it += 2 * gridDim.x) {
    float* tl0 = (float*)smem; float* tl1 = tl0 + 64 * 65;
    const bool two = (it + (int)gridDim.x) < NW_TILES;
    WTile wa, wb;
    decode_wtile(p, it, wa);
    decode_wtile(p, two ? it + (int)gridDim.x : it, wb);
    float4 va[4], vb[4];
    wtile_load(wa, va);
    wtile_load(wb, vb);
    wtile_to_lds(wa, va, tl0);
    wtile_to_lds(wb, vb, tl1);
    __syncthreads();
    wtile_store(wa, tl0);
    if (two) wtile_store(wb, tl1);
    __syncthreads();
  }
  for (int it = NW_TILES + blockIdx.x; it < total; it += gridDim.x) {
    if (false) {
    } else if (it < NW_TILES + NADA_ITEMS) {
      int a = it - NW_TILES;
      int kc = a & 31; int cc = (a >> 5) % 6; int mat = a / (32 * 6);
      float* sc = (float*)smem;
      if (tid < 128) { int b = tid >> 6, k = tid & 63; sc[tid] = siluf_(p.in[I_C][b * 2048 + kc * 64 + k]); }
      __syncthreads();
      const float* W = p.in[I_ADAW] + (size_t)mat * 2048 * 6144 + (size_t)(kc * 64) * 6144 + cc * 1024 + tid * 4;
      float4 a0 = make_float4(0.f, 0.f, 0.f, 0.f), a1 = a0;
#pragma unroll 8
      for (int k = 0; k < 64; ++k) {
        float4 w = *(const float4*)(W + (size_t)k * 6144);
        float s0 = sc[k], s1 = sc[64 + k];
        a0.x += s0 * w.x; a0.y += s0 * w.y; a0.z += s0 * w.z; a0.w += s0 * w.w;
        a1.x += s1 * w.x; a1.y += s1 * w.y; a1.z += s1 * w.z; a1.w += s1 * w.w;
      }
      float* part = (float*)(p.ws + O_ADAP);
      *(float4*)(part + ((size_t)(mat * 32 + kc) * 2 + 0) * 6144 + cc * 1024 + tid * 4) = a0;
      *(float4*)(part + ((size_t)(mat * 32 + kc) * 2 + 1) * 6144 + cc * 1024 + tid * 4) = a1;
      __syncthreads();
    } else if (it < NW_TILES + NADA_ITEMS + NCB1_ITEMS) {
      int a = it - NW_TILES - NADA_ITEMS;
      int j = a >> 4, kc = a & 15;
      const float* pe = p.in[I_CPE] + j * 4096 + kc * 256;
      const float* W = p.in[I_CW1] + (size_t)j * 4096 * 256 + (size_t)(kc * 256) * 256 + tid;
      float acc = 0.f;
#pragma unroll 8
      for (int k = 0; k < 256; ++k) acc += pe[k] * W[(size_t)k * 256];
      ((float*)(p.ws + O_CB1PART))[(j * 16 + kc) * 256 + tid] = acc;
    } else {
      int a = it - NW_TILES - NADA_ITEMS - NCB1_ITEMS;
      int e = a * 256 + tid;
      int t = e / 48, i = e % 48;
      float inv; int half, fi;
      if (i < 32) { half = 32; fi = i; } else { half = 16; fi = i - 32; }
      inv = powf(10000.0f, -(float)fi / (float)half);
      float angf = (float)t * inv;
      double ad = (double)angf;
      double kk = rint(ad * 0.15915494309189535);
      float r = (float)(ad - kk * 6.283185307179586);
      float cs = __cosf(r), sn = __sinf(r);
      if (i < 32) {
        float* R = (float*)(p.ws + O_ROPE64);
        R[t * 32 + fi] = cs; R[8192 * 32 + t * 32 + fi] = sn;
      } else {
        float* R = (float*)(p.ws + O_ROPE32);
        R[t * 16 + fi] = cs; R[8192 * 16 + t * 16 + fi] = sn;
      }
    }
  }
}

__device__ __forceinline__ void phase_reduce(const Params& p) {
  const int gtid = blockIdx.x * blockDim.x + TIDX, gsz = gridDim.x * blockDim.x;
  const float* part = (const float*)(p.ws + O_ADAP);
  float* M = (float*)(p.ws + O_ADAM);
  for (int e = gtid; e < 4 * 2 * 6144; e += gsz) {
    int n = e % 6144; int b = (e / 6144) & 1; int mat = e / (2 * 6144);
    float s = p.in[I_ADAB][mat * 6144 + n];
    for (int kc = 0; kc < 32; ++kc) s += part[((size_t)(mat * 32 + kc) * 2 + b) * 6144 + n];
    M[e] = s;
  }
  const float* cp = (const float*)(p.ws + O_CB1PART);
  float* C = (float*)(p.ws + O_CB1P);
  for (int e = gtid; e < 512; e += gsz) {
    int j = e >> 8, c = e & 255;
    float s = p.in[I_CB1][e];
    for (int kc = 0; kc < 16; ++kc) s += cp[(j * 16 + kc) * 256 + c];
    C[e] = s;
  }
}

__device__ __forceinline__ void phase_norm(const Params& p, const float* X, int mat) {
  const int lane = TIDX & 63, wave = TIDX >> 6;
  const float* g = p.in[I_NORMG] + mat * 2048;
  const float* M = (const float*)(p.ws + O_ADAM) + (size_t)mat * 2 * 6144;
  bf16_t* H = (bf16_t*)(p.ws + O_H);
  const int stride = gridDim.x * 4;
  int row = blockIdx.x * 4 + wave;
  f32x4 vn[8];
  if (row < NTOK) {
#pragma unroll
    for (int i = 0; i < 8; ++i) vn[i] = *(const f32x4*)(X + (size_t)row * 2048 + (i * 64 + lane) * 4);
  }
#pragma unroll 1
  for (; row < NTOK; row += stride) {
    const int b = row >> 13;
    f32x4 v[8]; float ss = 0.f;
#pragma unroll
    for (int i = 0; i < 8; ++i) { v[i] = vn[i]; ss += v[i].x * v[i].x + v[i].y * v[i].y + v[i].z * v[i].z + v[i].w * v[i].w; }
    {
      const int rn = (row + stride < NTOK) ? row + stride : row;
#pragma unroll
      for (int i = 0; i < 8; ++i) vn[i] = *(const f32x4*)(X + (size_t)rn * 2048 + (i * 64 + lane) * 4);
    }
    ss = wave_sum(ss);
    const float rs = rsqrtf(ss * (1.f / 2048.f) + EPSF);
    const float* sh = M + b * 6144; const float* scl = sh + 2048;
#pragma unroll
    for (int i = 0; i < 8; ++i) {
      int c = (i * 64 + lane) * 4;
      float4 gg = *(const float4*)(g + c), s4 = *(const float4*)(scl + c), h4 = *(const float4*)(sh + c);
      float y0 = v[i].x * rs * gg.x * (1.f + s4.x) + h4.x;
      float y1 = v[i].y * rs * gg.y * (1.f + s4.y) + h4.y;
      float y2 = v[i].z * rs * gg.z * (1.f + s4.z) + h4.z;
      float y3 = v[i].w * rs * gg.w * (1.f + s4.w) + h4.w;
      *(uint2*)(H + (size_t)row * 2048 + c) = make_uint2(pack2(y0, y1), pack2(y2, y3));
    }
  }
}

__device__ __forceinline__ void gemm_core(const bf16_t* __restrict__ A, long lda, int rowA0, int rowLo, int rowHi,
                                          const bf16_t* __restrict__ Bt, long ldb, int K, unsigned char* smem) {
  bf16_t* As = (bf16_t*)smem; bf16_t* Bs = As + 128 * 64;
  float* Cs = (float*)smem;
  const int tid = TIDX, lane = tid & 63, wave = tid >> 6;
  const int wm = wave >> 1, wn = wave & 1, l31 = lane & 31, hh = lane >> 5;
  f32x16 acc[2][2];
#pragma unroll
  for (int i = 0; i < 2; ++i)
#pragma unroll
    for (int j = 0; j < 2; ++j)
#pragma unroll
      for (int r = 0; r < 16; ++r) acc[i][j][r] = 0.f;
  u32x4 ra0[4], rb0[4], ra1[4], rb1[4];
#define GLOAD(RA, RB, KOFF)                                                                                   \
  _Pragma("unroll") for (int i = 0; i < 4; ++i) {                                                             \
    int c = tid + i * 256, row = c >> 3, kc = c & 7; int rr = rowA0 + row;                                    \
    u32x4 va = {0u, 0u, 0u, 0u};                                                                              \
    if (rr >= rowLo && rr < rowHi) va = *(const u32x4*)(A + (long)rr * lda + (KOFF) + kc * 8);                \
    RA[i] = va;                                                                                               \
    RB[i] = *(const u32x4*)(Bt + (long)row * ldb + (KOFF) + kc * 8);                                          \
  }
#define LSTORE(RA, RB)                                                                                        \
  _Pragma("unroll") for (int i = 0; i < 4; ++i) {                                                             \
    int c = tid + i * 256, row = c >> 3, kc = c & 7;                                                          \
    *(u32x4*)(As + row * 64 + ((kc ^ ((row >> 1) & 7)) << 3)) = RA[i];                                        \
    *(u32x4*)(Bs + row * 64 + ((kc ^ ((row >> 1) & 7)) << 3)) = RB[i];                                        \
  }
#define KSTEP()                                                                                               \
  __builtin_amdgcn_s_setprio(1);                                                                              \
  _Pragma("unroll") for (int ks = 0; ks < 4; ++ks) {                                                          \
    const int sw = (((ks * 2 + hh) ^ ((l31 >> 1) & 7)) << 3);                                                 \
    bf16x8 a0 = *(const bf16x8*)(As + (wm * 64 + l31) * 64 + sw);                                             \
    bf16x8 a1 = *(const bf16x8*)(As + (wm * 64 + 32 + l31) * 64 + sw);                                        \
    bf16x8 b0 = *(const bf16x8*)(Bs + (wn * 64 + l31) * 64 + sw);                                             \
    bf16x8 b1 = *(const bf16x8*)(Bs + (wn * 64 + 32 + l31) * 64 + sw);                                        \
    acc[0][0] = MFMA_BF16(a0, b0, acc[0][0]);                                                                 \
    acc[0][1] = MFMA_BF16(a0, b1, acc[0][1]);                                                                 \
    acc[1][0] = MFMA_BF16(a1, b0, acc[1][0]);                                                                 \
    acc[1][1] = MFMA_BF16(a1, b1, acc[1][1]);                                                                 \
  }                                                                                                           \
  __builtin_amdgcn_s_setprio(0);
  GLOAD(ra0, rb0, 0)
  GLOAD(ra1, rb1, 64)
#pragma unroll 1
  for (int k0 = 0; k0 < K; k0 += 128) {
    LSTORE(ra0, rb0)
    __syncthreads();
    if (k0 + 128 < K) { GLOAD(ra0, rb0, k0 + 128) }
    KSTEP()
    __syncthreads();
    LSTORE(ra1, rb1)
    __syncthreads();
    if (k0 + 192 < K) { GLOAD(ra1, rb1, k0 + 192) }
    KSTEP()
    __syncthreads();
  }
#undef GLOAD
#undef LSTORE
#undef KSTEP
#pragma unroll
  for (int i = 0; i < 2; ++i)
#pragma unroll
    for (int j = 0; j < 2; ++j)
#pragma unroll
      for (int r = 0; r < 16; ++r) {
        int row = wm * 64 + i * 32 + (r & 3) + 8 * (r >> 2) + 4 * hh;
        int col = wn * 64 + j * 32 + l31;
        Cs[row * 129 + col] = acc[i][j][r];
      }
  __syncthreads();
}

__device__ __forceinline__ void gemm_core2(const bf16_t* __restrict__ A, long lda, int rowA0, int rowLo, int rowHi,
                                           const bf16_t* __restrict__ Bt, long ldb, int K, unsigned char* smem, f32x16 (&acc)[2][4]) {
  bf16_t* As = (bf16_t*)smem; bf16_t* Bs = As + 128 * 64;
  const int tid = TIDX, lane = tid & 63, wave = tid >> 6;
  const int wm = wave >> 1, wn = wave & 1, l31 = lane & 31, hh = lane >> 5;
#pragma unroll
  for (int i = 0; i < 2; ++i)
#pragma unroll
    for (int j = 0; j < 4; ++j)
#pragma unroll
      for (int r = 0; r < 16; ++r) acc[i][j][r] = 0.f;
  u32x4 ra[4], rb[8];
#define GLOAD2(KOFF)                                                                                          \
  _Pragma("unroll") for (int i = 0; i < 4; ++i) {                                                             \
    int c = tid + i * 256, row = c >> 3, kc = c & 7; int rr = rowA0 + row;                                    \
    u32x4 va = {0u, 0u, 0u, 0u};                                                                              \
    if (rr >= rowLo && rr < rowHi) va = *(const u32x4*)(A + (long)rr * lda + (KOFF) + kc * 8);                \
    ra[i] = va;                                                                                               \
  }                                                                                                           \
  _Pragma("unroll") for (int i = 0; i < 8; ++i) {                                                             \
    int c = tid + i * 256, row = c >> 3, kc = c & 7;                                                          \
    rb[i] = *(const u32x4*)(Bt + (long)row * ldb + (KOFF) + kc * 8);                                          \
  }
  GLOAD2(0)
#pragma unroll 1
  for (int k0 = 0; k0 < K; k0 += 64) {
#pragma unroll
    for (int i = 0; i < 4; ++i) {
      int c = tid + i * 256, row = c >> 3, kc = c & 7;
      *(u32x4*)(As + row * 64 + ((kc ^ ((row >> 1) & 7)) << 3)) = ra[i];
    }
#pragma unroll
    for (int i = 0; i < 8; ++i) {
      int c = tid + i * 256, row = c >> 3, kc = c & 7;
      *(u32x4*)(Bs + row * 64 + ((kc ^ ((row >> 1) & 7)) << 3)) = rb[i];
    }
    __syncthreads();
    if (k0 + 64 < K) { GLOAD2(k0 + 64) }
    __builtin_amdgcn_s_setprio(1);
#pragma unroll
    for (int ks = 0; ks < 4; ++ks) {
      const int sw = (((ks * 2 + hh) ^ ((l31 >> 1) & 7)) << 3);
      bf16x8 a0 = *(const bf16x8*)(As + (wm * 64 + l31) * 64 + sw);
      bf16x8 a1 = *(const bf16x8*)(As + (wm * 64 + 32 + l31) * 64 + sw);
#pragma unroll
      for (int j = 0; j < 4; ++j) {
        bf16x8 bj = *(const bf16x8*)(Bs + (wn * 128 + j * 32 + l31) * 64 + sw);
        acc[0][j] = MFMA_BF16(a0, bj, acc[0][j]);
        acc[1][j] = MFMA_BF16(a1, bj, acc[1][j]);
      }
    }
    __builtin_amdgcn_s_setprio(0);
    __syncthreads();
  }
#undef GLOAD2
}
__device__ __forceinline__ void stage_half(const f32x16 (&acc)[2][4], int h, float* Cs) {
  const int tid = TIDX, lane = tid & 63, wave = tid >> 6;
  const int wm = wave >> 1, wn = wave & 1, l31 = lane & 31, hh = lane >> 5;
  if (wn == h) {
#pragma unroll
    for (int i = 0; i < 2; ++i)
#pragma unroll
      for (int j = 0; j < 4; ++j)
#pragma unroll
        for (int r = 0; r < 16; ++r)
          Cs[(wm * 64 + i * 32 + (r & 3) + 8 * (r >> 2) + 4 * hh) * 129 + j * 32 + l31] = acc[i][j][r];
  }
  __syncthreads();
}

#define CSV(r, c) Cs[(r) * 129 + (c)]

__device__ __forceinline__ void epi_rms128(const float* Cs, const float* g, bf16_t* dst, long dst_ld, const float* rowscale) {
  const int lane = TIDX & 63, wave = TIDX >> 6;
  const float g0 = g[2 * lane], g1 = g[2 * lane + 1];
#pragma unroll 1
  for (int i = 0; i < 32; ++i) {
    int r = wave * 32 + i;
    float v0 = CSV(r, 2 * lane), v1 = CSV(r, 2 * lane + 1);
    if (rowscale) { float s = rowscale[r]; v0 *= s; v1 *= s; }
    float ss = wave_sum(v0 * v0 + v1 * v1);
    float rs = rsqrtf(ss * (1.f / 128.f) + EPSF);
    *(unsigned*)(dst + (long)r * dst_ld + 2 * lane) = pack2(v0 * rs * g0, v1 * rs * g1);
  }
}
__device__ __forceinline__ void epi_raw(const float* Cs, bf16_t* dst, long dst_ld) {
  const int lane = TIDX & 63, wave = TIDX >> 6;
#pragma unroll 1
  for (int i = 0; i < 32; ++i) {
    int r = wave * 32 + i;
    *(unsigned*)(dst + (long)r * dst_ld + 2 * lane) = pack2(CSV(r, 2 * lane), CSV(r, 2 * lane + 1));
  }
}
__device__ __forceinline__ void epi_transposed(const float* Cs, bf16_t* dst, long dst_ld, const float* rowscale) {
  const int lane = TIDX & 63, wave = TIDX >> 6;
  float s0 = 1.f, s1 = 1.f;
  if (rowscale) { s0 = rowscale[2 * lane]; s1 = rowscale[2 * lane + 1]; }
#pragma unroll 1
  for (int i = 0; i < 32; ++i) {
    int d = wave * 32 + i;
    *(unsigned*)(dst + (long)d * dst_ld + 2 * lane) = pack2(CSV(2 * lane, d) * s0, CSV(2 * lane + 1, d) * s1);
  }
}

__device__ __forceinline__ void evin_epi(const Params& p, float* Cs, int tm, int tn) {
  unsigned char* ws = p.ws;
  const int lane = TIDX & 63, wave = TIDX >> 6;
  const float* rope = (const float*)(ws + O_ROPE64);
    const int tok0 = tm * 128, b = tok0 >> 13, t0 = tok0 & 8191;
    if (tn < 8) {
      epi_rms128(Cs, p.in[I_NSAG], (bf16_t*)(ws + O_QN) + ((size_t)(b * 8 + tn) * 8192 + t0) * 128, 128, nullptr);
    } else if (tn < 20) {
      int idx = tn - 8, j = idx >> 1, g = idx & 1;
      if (j < 2) epi_raw(Cs, (bf16_t*)(ws + O_KVSRC) + ((size_t)((j * 2 + b) * 2 + g) * 8192 + t0) * 128, 128);
      else if (j == 2) epi_rms128(Cs, p.in[I_NSAG] + 128, (bf16_t*)(ws + O_KSLC) + ((size_t)(b * 2 + g) * 8192 + t0) * 128, 128, nullptr);
      else if (j == 4) epi_rms128(Cs, p.in[I_NSAG] + 128, (bf16_t*)(ws + O_KWIN) + ((size_t)(b * 2 + g) * 8192 + t0) * 128, 128, nullptr);
      else if (j == 3) epi_transposed(Cs, (bf16_t*)(ws + O_VSLCT) + (size_t)(b * 2 + g) * 128 * 8192 + t0, 8192, nullptr);
      else epi_transposed(Cs, (bf16_t*)(ws + O_VWINT) + (size_t)(b * 2 + g) * 128 * 8192 + t0, 8192, nullptr);
    } else if (tn < 26) {
      bf16_t* dst; int ld, slot;
      if (tn < 24) { dst = (bf16_t*)(ws + O_CQ) + (size_t)tok0 * 512 + (tn - 20) * 128; ld = 512; slot = tn - 20; }
      else { dst = (bf16_t*)(ws + O_CKV) + (size_t)tok0 * 256 + (tn - 24) * 128; ld = 256; slot = 4 + tn - 24; }
      float* ssq = (float*)(ws + O_SSQ);
    #pragma unroll 1
  for (int i = 0; i < 32; ++i) {
        int r = wave * 32 + i;
        float v0 = CSV(r, 2 * lane), v1 = CSV(r, 2 * lane + 1);
        float ss = wave_sum(v0 * v0 + v1 * v1);
        *(unsigned*)(dst + (long)r * ld + 2 * lane) = pack2(v0, v1);
        if (lane == 0) ssq[(size_t)(tok0 + r) * 8 + slot] = ss;
      }
    } else {
      const float* g = p.in[I_ROPEG] + 64;
      const int c0 = 2 * (lane & 31);
      const float g0 = g[c0], g1 = g[c0 + 1];
      bf16_t* kml = (bf16_t*)(ws + O_KMLA);
      float* gates = (float*)(ws + O_GATES);
      const int ci = c0 & 31;
      float2 csn = *(const float2*)(rope + (t0 + wave * 32) * 32 + ci), snn = *(const float2*)(rope + 8192 * 32 + (t0 + wave * 32) * 32 + ci);
    #pragma unroll 1
  for (int i = 0; i < 32; ++i) {
        int r = wave * 32 + i, t = t0 + r;
        float v0 = CSV(r, 2 * lane), v1 = CSV(r, 2 * lane + 1);
        float ss = half_sum(v0 * v0 + v1 * v1);
        float rs = rsqrtf(ss * (1.f / 64.f) + EPSF);
        float y0 = v0 * rs * g0, y1 = v1 * rs * g1;
        float q0 = __shfl_xor(y0, 16), q1 = __shfl_xor(y1, 16);
        const float2 cs = csn, sn = snn;
        { const int tnx = (i + 1 < 32) ? t + 1 : t; csn = *(const float2*)(rope + tnx * 32 + ci); snn = *(const float2*)(rope + 8192 * 32 + tnx * 32 + ci); }
        if (lane < 32) {
          float o0, o1;
          if (lane < 16) { o0 = y0 * cs.x - q0 * sn.x; o1 = y1 * cs.y - q1 * sn.y; }
          else { o0 = q0 * sn.x + y0 * cs.x; o1 = q1 * sn.y + y1 * cs.y; }
          unsigned pk = pack2(o0, o1);
#pragma unroll
          for (int hd = 0; hd < 8; ++hd) *(unsigned*)(kml + ((size_t)(b * 8 + hd) * 8192 + t) * 192 + 128 + c0) = pk;
        } else if (lane < 44) {
          int gi = 2 * (lane - 32);
          gates[(size_t)(tok0 + r) * 24 + gi] = sigmoidf_(v0);
          gates[(size_t)(tok0 + r) * 24 + gi + 1] = sigmoidf_(v1);
        }
      }
    }
}
__device__ __forceinline__ void phase_evin(const Params& p, unsigned char* smem) {
  unsigned char* ws = p.ws;
  float* Cs = (float*)smem;
#pragma unroll 1
  for (int it = blockIdx.x; it < 128 * 12; it += gridDim.x) {
    const int tn2 = it % 12, tm = it / 12;
    f32x16 acc[2][4];
    gemm_core2((const bf16_t*)(ws + O_H), 2048, tm * 128, 0, NTOK, (const bf16_t*)(ws + O_WEVIN) + (size_t)tn2 * 256 * 2048, 2048, 2048, smem, acc);
#pragma unroll 1
    for (int h = 0; h < 2; ++h) {
      stage_half(acc, h, Cs);
      evin_epi(p, Cs, tm, tn2 * 2 + h);
      __syncthreads();
    }
  }
#pragma unroll 1
  for (int it = blockIdx.x; it < 128 * 3; it += gridDim.x) {
    const int tn = 24 + it % 3, tm = it / 3;
    gemm_core((const bf16_t*)(ws + O_H), 2048, tm * 128, 0, NTOK, (const bf16_t*)(ws + O_WEVIN) + (size_t)tn * 128 * 2048, 2048, 2048, smem);
    evin_epi(p, Cs, tm, tn);
    __syncthreads();
  }
}

__device__ __forceinline__ void phase_mid(const Params& p, unsigned char* smem) {
  unsigned char* ws = p.ws;
  float* Cs = (float*)smem;
  float* rsc = (float*)(smem + 66048);
  const int lane = TIDX & 63, wave = TIDX >> 6;
  const int n_cmp = 64, n_uq = 128 * 12, n_ukv = 128 * 16;
  const float* rope = (const float*)(ws + O_ROPE64);
  const float* ssq = (const float*)(ws + O_SSQ);
#pragma unroll 1
  for (int it = blockIdx.x; it < n_cmp; it += gridDim.x) {
    {
      int pidx = it >> 3, tm = (it >> 1) & 3, tn = it & 1;
      int j = pidx >> 2;
      gemm_core((const bf16_t*)(ws + O_KVSRC) + (size_t)pidx * 8192 * 128, 2048, tm * 128, 0, 511,
                (const bf16_t*)(ws + O_WCW1) + (size_t)j * 256 * 4096 + (size_t)tn * 128 * 4096, 4096, 4096, smem);
      const float* cb = (const float*)(ws + O_CB1P) + j * 256 + tn * 128;
      bf16_t* hid = (bf16_t*)(ws + O_HID) + ((size_t)pidx * 512 + tm * 128) * 256 + tn * 128;
      const float b0 = cb[2 * lane], b1 = cb[2 * lane + 1];
    #pragma unroll 1
  for (int i = 0; i < 32; ++i) {
        int r = wave * 32 + i;
        *(unsigned*)(hid + (long)r * 256 + 2 * lane) = pack2(geluf_(CSV(r, 2 * lane) + b0), geluf_(CSV(r, 2 * lane + 1) + b1));
      }
    }
    __syncthreads();
  }
#pragma unroll 1
  for (int it = blockIdx.x; it < n_uq; it += gridDim.x) {
    {
      int a = it; int tn = a % 12, tm = a / 12;
      gemm_core((const bf16_t*)(ws + O_CQ), 512, tm * 128, 0, NTOK, (const bf16_t*)(ws + O_WUQ) + (size_t)tn * 128 * 512, 512, 512, smem);
      const int tok0 = tm * 128, b = tok0 >> 13, t0 = tok0 & 8191;
      if (TIDX < 128) {
        const float* s = ssq + (size_t)(tok0 + TIDX) * 8;
        rsc[TIDX] = rsqrtf((s[0] + s[1] + s[2] + s[3]) * (1.f / 512.f) + EPSF);
      }
      __syncthreads();
      bf16_t* qm = (bf16_t*)(ws + O_QMLA);
      if (tn < 8) {
        epi_rms128(Cs, p.in[I_NOPEG], qm + ((size_t)(b * 8 + tn) * 8192 + t0) * 192, 192, rsc);
      } else {
        const float* g = p.in[I_ROPEG];
        const int c0 = 2 * (lane & 31), hd = 2 * (tn - 8) + (lane >> 5), l31 = lane & 31;
        const float g0 = g[c0], g1 = g[c0 + 1];
        const int ci = c0 & 31;
        float2 csn = *(const float2*)(rope + (t0 + wave * 32) * 32 + ci), snn = *(const float2*)(rope + 8192 * 32 + (t0 + wave * 32) * 32 + ci);
      #pragma unroll 1
  for (int i = 0; i < 32; ++i) {
          int r = wave * 32 + i, t = t0 + r;
          float sc = rsc[r];
          float v0 = CSV(r, 2 * lane) * sc, v1 = CSV(r, 2 * lane + 1) * sc;
          float ss = half_sum(v0 * v0 + v1 * v1);
          float rs = rsqrtf(ss * (1.f / 64.f) + EPSF);
          float y0 = v0 * rs * g0, y1 = v1 * rs * g1;
          float q0 = __shfl_xor(y0, 16), q1 = __shfl_xor(y1, 16);
          const float2 cs = csn, sn = snn;
          { const int tnx = (i + 1 < 32) ? t + 1 : t; csn = *(const float2*)(rope + tnx * 32 + ci); snn = *(const float2*)(rope + 8192 * 32 + tnx * 32 + ci); }
          float o0, o1;
          if (l31 < 16) { o0 = y0 * cs.x - q0 * sn.x; o1 = y1 * cs.y - q1 * sn.y; }
          else { o0 = q0 * sn.x + y0 * cs.x; o1 = q1 * sn.y + y1 * cs.y; }
          *(unsigned*)(qm + ((size_t)(b * 8 + hd) * 8192 + t) * 192 + 128 + c0) = pack2(o0, o1);
        }
      }
    }
    __syncthreads();
  }
#pragma unroll 1
  for (int it = blockIdx.x; it < n_ukv; it += gridDim.x) {
    {
      int a = it; int tn = a & 15, tm = a >> 4;
      gemm_core((const bf16_t*)(ws + O_CKV), 256, tm * 128, 0, NTOK, (const bf16_t*)(ws + O_WUKV) + (size_t)tn * 128 * 256, 256, 256, smem);
      const int tok0 = tm * 128, b = tok0 >> 13, t0 = tok0 & 8191, hd = tn >> 1;
      if (TIDX < 128) {
        const float* s = ssq + (size_t)(tok0 + TIDX) * 8;
        rsc[TIDX] = rsqrtf((s[4] + s[5]) * (1.f / 256.f) + EPSF);
      }
      __syncthreads();
      if ((tn & 1) == 0) epi_rms128(Cs, p.in[I_NOPEG] + 128, (bf16_t*)(ws + O_KMLA) + ((size_t)(b * 8 + hd) * 8192 + t0) * 192, 192, rsc);
      else epi_transposed(Cs, (bf16_t*)(ws + O_VMLAT) + (size_t)(b * 8 + hd) * 128 * 8192 + t0, 8192, rsc);
    }
    __syncthreads();
  }
}

__device__ __forceinline__ void phase_cmp2(const Params& p, unsigned char* smem) {
  unsigned char* ws = p.ws;
  float* Cs = (float*)smem;
  const int lane = TIDX & 63, wave = TIDX >> 6;
  for (int it = blockIdx.x; it < 32; it += gridDim.x) {
    int pidx = it >> 2, tm = it & 3;
    int j = pidx >> 2, bg = pidx & 3;
    gemm_core((const bf16_t*)(ws + O_HID) + (size_t)pidx * 512 * 256, 256, tm * 128, 0, 512,
              (const bf16_t*)(ws + O_WCW2) + (size_t)j * 128 * 256, 256, 256, smem);
    const float* b2 = p.in[I_CB2] + j * 128;
  #pragma unroll 1
  for (int i = 0; i < 32; ++i) {
      int r = wave * 32 + i;
      CSV(r, 2 * lane) += b2[2 * lane]; CSV(r, 2 * lane + 1) += b2[2 * lane + 1];
    }
    __syncthreads();
    if (j == 0) epi_rms128(Cs, p.in[I_NSAG] + 128, (bf16_t*)(ws + O_KCMP) + ((size_t)bg * 512 + tm * 128) * 128, 128, nullptr);
    else epi_transposed(Cs, (bf16_t*)(ws + O_VCMPT) + (size_t)bg * 128 * 512 + tm * 128, 512, nullptr);
    __syncthreads();
  }
}

__device__ __forceinline__ void phase_resid(const Params& p, const bf16_t* A, int K, const bf16_t* Bt, const float* src, float* dst, int mat, unsigned char* smem) {
  float* Cs = (float*)smem;
  const int lane = TIDX & 63, wave = TIDX >> 6;
  const float* M = (const float*)(p.ws + O_ADAM) + (size_t)mat * 2 * 6144;
  for (int it = blockIdx.x; it < 128 * 8; it += gridDim.x) {
    const int tn2 = it & 7, tm = it >> 3;
    f32x16 acc[2][4];
    gemm_core2(A, K, tm * 128, 0, NTOK, Bt + (size_t)tn2 * 256 * K, K, K, smem, acc);
#pragma unroll 1
    for (int h = 0; h < 2; ++h) {
    stage_half(acc, h, Cs);
    const int tn = tn2 * 2 + h;
    const int tok0 = tm * 128, b = tok0 >> 13;
    const int col = tn * 128 + 2 * lane;
    const float g0 = M[b * 6144 + 4096 + col], g1 = M[b * 6144 + 4096 + col + 1];
#pragma unroll 1
    for (int i0 = 0; i0 < 32; i0 += 8) {
      f32x2_t sv[8];
#pragma unroll
      for (int j = 0; j < 8; ++j) sv[j] = *(const f32x2_t*)(src + (size_t)(tok0 + wave * 32 + i0 + j) * 2048 + col);
#pragma unroll
      for (int j = 0; j < 8; ++j) {
        const int r = wave * 32 + i0 + j;
        f32x2_t d = {sv[j].x + g0 * CSV(r, 2 * lane), sv[j].y + g1 * CSV(r, 2 * lane + 1)};
        *(f32x2_t*)(dst + (size_t)(tok0 + r) * 2048 + col) = d;
      }
    }
    __syncthreads();
    }
  }
}

__device__ __forceinline__ void phase_ffn_up(const Params& p, int layer, unsigned char* smem) {
  float* Cs = (float*)smem;
  const int lane = TIDX & 63, wave = TIDX >> 6;
  const bf16_t* Bt = (const bf16_t*)(p.ws + O_WUP) + (size_t)layer * 8192 * 2048;
  const float* cw = p.in[I_FCW] + (size_t)layer * 3 * 8192;
  const float* cb = p.in[I_FCB] + (size_t)layer * 8192;
  bf16_t* act = (bf16_t*)(p.ws + O_ACT);
  for (int it = blockIdx.x; it < 132 * 32; it += gridDim.x) {
    const int tn2 = it & 31, tmi = it >> 5;
    const int b = tmi / 66, i66 = tmi % 66;
    const int rowA0 = b * 8192 + i66 * 126 - 2;
    f32x16 acc[2][4];
    gemm_core2((const bf16_t*)(p.ws + O_H), 2048, rowA0, b * 8192, (b + 1) * 8192, Bt + (size_t)tn2 * 256 * 2048, 2048, 2048, smem, acc);
#pragma unroll 1
    for (int h = 0; h < 2; ++h) {
    stage_half(acc, h, Cs);
    const int tn = tn2 * 2 + h;
    const int cg_ = tn * 64 + lane, cv_ = 4096 + tn * 64 + lane;
    const float wg0 = cw[cg_], wg1 = cw[8192 + cg_], wg2 = cw[16384 + cg_], bg = cb[cg_];
    const float wv0 = cw[cv_], wv1 = cw[8192 + cv_], wv2 = cw[16384 + cv_], bv = cb[cv_];
  #pragma unroll 1
  for (int i = 0; i < 32; ++i) {
      int r = wave * 32 + i;
      if (r < 2) continue;
      int tok = rowA0 + r;
      if (tok >= (b + 1) * 8192) continue;
      float ug = wg0 * CSV(r - 2, lane) + wg1 * CSV(r - 1, lane) + wg2 * CSV(r, lane) + bg;
      float uv = wv0 * CSV(r - 2, 64 + lane) + wv1 * CSV(r - 1, 64 + lane) + wv2 * CSV(r, 64 + lane) + bv;
      act[(size_t)tok * 4096 + tn * 64 + lane] = f2bf(siluf_(ug) * uv);
    }
    __syncthreads();
    }
  }
}

__device__ __forceinline__ void odin_epi(const Params& p, float* Cs, int tm, int tn) {
  unsigned char* ws = p.ws;
  const int lane = TIDX & 63, wave = TIDX >> 6;
  const float* rope = (const float*)(ws + O_ROPE32);
    const int tok0 = tm * 128, b = tok0 >> 13, t0 = tok0 & 8191;
    if (tn < 16) {
      epi_rms128(Cs, p.in[I_DSAG], (bf16_t*)(ws + O_QD) + ((size_t)(b * 16 + tn) * 8192 + t0) * 128, 128, nullptr);
    } else if (tn < 20) {
      epi_rms128(Cs, p.in[I_DSAG] + 128, (bf16_t*)(ws + O_KD) + ((size_t)(b * 4 + tn - 16) * 8192 + t0) * 128, 128, nullptr);
    } else if (tn < 24) {
      epi_transposed(Cs, (bf16_t*)(ws + O_VDT) + (size_t)(b * 4 + tn - 20) * 128 * 8192 + t0, 8192, nullptr);
    } else {
      const int l31 = lane & 31, c0 = 2 * l31;
      _Float16* iq = (_Float16*)(ws + O_IQ);
      _Float16* ik = (_Float16*)(ws + O_IK);
      float* iw = (float*)(ws + O_IW);
      const int ci = c0 & 15;
      float2 csn = *(const float2*)(rope + (t0 + wave * 32) * 16 + ci), snn = *(const float2*)(rope + 8192 * 16 + (t0 + wave * 32) * 16 + ci);
    #pragma unroll 1
  for (int i = 0; i < 32; ++i) {
        int r = wave * 32 + i, t = t0 + r;
        float v0 = CSV(r, 2 * lane), v1 = CSV(r, 2 * lane + 1);
        float q0 = __shfl_xor(v0, 8), q1 = __shfl_xor(v1, 8);
        float o0 = v0, o1 = v1;
        const float2 cs = csn, sn = snn;
        { const int tnx = (i + 1 < 32) ? t + 1 : t; csn = *(const float2*)(rope + tnx * 16 + ci); snn = *(const float2*)(rope + 8192 * 16 + tnx * 16 + ci); }
        if (l31 < 8) { o0 = v0 * cs.x - q0 * sn.x; o1 = v1 * cs.y - q1 * sn.y; }
        else if (l31 < 16) { o0 = q0 * sn.x + v0 * cs.x; o1 = q1 * sn.y + v1 * cs.y; }
        if (tn < 32) {
          int ih = 2 * (tn - 24) + (lane >> 5);
          _Float16* d = iq + ((size_t)(tok0 + r) * 16 + ih) * 64 + c0;
          d[0] = (_Float16)(o0 * 0.125f); d[1] = (_Float16)(o1 * 0.125f);
        } else if (lane < 32) {
          _Float16* d = ik + (size_t)(tok0 + r) * 64 + c0;
          d[0] = (_Float16)o0; d[1] = (_Float16)o1;
        } else if (lane < 40) {
          int wi = 2 * (lane - 32);
          iw[(size_t)(tok0 + r) * 16 + wi] = v0 * 0.25f;
          iw[(size_t)(tok0 + r) * 16 + wi + 1] = v1 * 0.25f;
        }
      }
    }
}
__device__ __forceinline__ void phase_odin(const Params& p, unsigned char* smem) {
  unsigned char* ws = p.ws;
  float* Cs = (float*)smem;
#pragma unroll 1
  for (int it = blockIdx.x; it < 128 * 16; it += gridDim.x) {
    const int tn2 = it & 15, tm = it >> 4;
    f32x16 acc[2][4];
    gemm_core2((const bf16_t*)(ws + O_H), 2048, tm * 128, 0, NTOK, (const bf16_t*)(ws + O_WODIN) + (size_t)tn2 * 256 * 2048, 2048, 2048, smem, acc);
#pragma unroll 1
    for (int h = 0; h < 2; ++h) {
      stage_half(acc, h, Cs);
      odin_epi(p, Cs, tm, tn2 * 2 + h);
      __syncthreads();
    }
  }
#pragma unroll 1
  for (int tm = blockIdx.x; tm < 128; tm += gridDim.x) {
    gemm_core((const bf16_t*)(ws + O_H), 2048, tm * 128, 0, NTOK, (const bf16_t*)(ws + O_WODIN) + (size_t)32 * 128 * 2048, 2048, 2048, smem);
    odin_epi(p, Cs, tm, 32);
    __syncthreads();
  }
}

template <int DQK>
__device__ __forceinline__ void compute_st(const bf16_t* Ks, int kb, const bf16x8 (&qf)[8], const bf16_t* Qs, int l31, int hh, f32x16& st) {
#pragma unroll
  for (int r = 0; r < 16; ++r) st[r] = 0.f;
  __builtin_amdgcn_s_setprio(1);
#pragma unroll
  for (int ks = 0; ks < DQK / 16; ++ks) {
    bf16x8 a0 = *(const bf16x8*)(Ks + (kb * 32 + l31) * (DQK + 8) + ks * 16 + hh * 8);
    bf16x8 bq;
    if (ks < 8) bq = qf[ks < 8 ? ks : 0];
    else bq = *(const bf16x8*)(Qs + (ks - 8) * 16 + hh * 8);
    st = MFMA_BF16(a0, bq, st);
  }
  __builtin_amdgcn_s_setprio(0);
}

template <int MODE>
__device__ __forceinline__ float mask_val(float sraw, int d, float scale, const float* lut, bool far, float lutfar, bool tilebit, unsigned mw, int bitpos) {
  bool ok = d >= 0;
  if (MODE == 1) ok = ok && d < 512;
  if (MODE == 2) ok = ok && tilebit;
  if (MODE == 3) ok = ok && ((mw >> bitpos) & 1u);
  float bias = 0.f;
  if (MODE != 0) {
    if (far) bias = lutfar;
    else { int di = d < 0 ? 0 : (d > 128 ? 128 : d); bias = lut[di]; }
  }
  return ok ? sraw * scale + bias : NEG_INF;
}

template <int DQK, int MODE>
__device__ __forceinline__ void flash_loop(const bf16_t* __restrict__ Kg, const bf16_t* __restrict__ Vtg, int vt_ld, int kt_lo, int kt_hi,
                                           const bf16x8 (&qf)[8], const bf16_t* Qs, int t, int tmin_wave, float scale, const float* lut,
                                           u64 sel0, u64 sel1, const u64* mrow, unsigned char* smem,
                                           f32x16 (&o)[4], float& m_run, float& l_run) {
  constexpr int LDK = DQK + 8, KCH = DQK / 8, NKC = 64 * KCH / 256;
  bf16_t* Ks = (bf16_t*)smem; bf16_t* Vs = Ks + 64 * LDK;
  constexpr int VLD = 68;
  const int tid = TIDX, lane = tid & 63, l31 = lane & 31, hh = lane >> 5;
  const float lutfar = (MODE != 0) ? lut[128] : 0.f;
  const float scale2 = scale * LOG2E;
#pragma unroll
  for (int i = 0; i < 4; ++i) {
#pragma unroll
    for (int r = 0; r < 16; ++r) o[i][r] = 0.f;
  }
  m_run = NEG_INF; l_run = 0.f;
  constexpr bool PREF = (MODE != 4);
  u32x4 pk[4], pv[4];
  u64 mw_next = 0;
  if (PREF && kt_lo < kt_hi) {
#pragma unroll
    for (int i = 0; i < 4; ++i) { int row = (tid >> 4) + i * 16, cc = tid & 15; pk[i] = *(const u32x4*)(Kg + (size_t)(kt_lo * 64 + row) * DQK + cc * 8); }
    {
#pragma unroll
      for (int i = 0; i < 4; ++i) { int c = tid + i * 256, row = c >> 3, cc = c & 7; pv[i] = *(const u32x4*)(Vtg + (size_t)row * vt_ld + kt_lo * 64 + cc * 8); }
    }
    if (MODE == 3) mw_next = mrow[kt_lo];
  }
#pragma unroll 1
  for (int kt = kt_lo; kt < kt_hi; ++kt) {
    __syncthreads();
    u64 mw = 0;
    if (PREF) {
#pragma unroll
      for (int i = 0; i < 4; ++i) { int row = (tid >> 4) + i * 16, cc = tid & 15; *(u32x4*)(Ks + row * LDK + cc * 8) = pk[i]; }
      if (DQK > 128) {
#pragma unroll
        for (int i = 0; i < 2; ++i) { int row = (tid >> 3) + i * 32, cc = 16 + (tid & 7); *(u32x4*)(Ks + row * LDK + cc * 8) = *(const u32x4*)(Kg + (size_t)(kt * 64 + row) * DQK + cc * 8); }
      }
      {
#pragma unroll
        for (int i = 0; i < 4; ++i) { int c = tid + i * 256, row = c >> 3, cc = c & 7; u32x2 lo2 = {pv[i].x, pv[i].y}, hi2 = {pv[i].z, pv[i].w}; *(u32x2*)(Vs + row * VLD + cc * 8) = lo2; *(u32x2*)(Vs + row * VLD + cc * 8 + 4) = hi2; }
      }
      mw = mw_next;
    } else {
#pragma unroll
      for (int i = 0; i < 4; ++i) { int row = (tid >> 4) + i * 16, cc = tid & 15; *(u32x4*)(Ks + row * LDK + cc * 8) = *(const u32x4*)(Kg + (size_t)(kt * 64 + row) * DQK + cc * 8); }
      if (DQK > 128) {
#pragma unroll
        for (int i = 0; i < 2; ++i) { int row = (tid >> 3) + i * 32, cc = 16 + (tid & 7); *(u32x4*)(Ks + row * LDK + cc * 8) = *(const u32x4*)(Kg + (size_t)(kt * 64 + row) * DQK + cc * 8); }
      }
#pragma unroll
      for (int i = 0; i < 4; ++i) { int c = tid + i * 256, row = c >> 3, cc = c & 7; const u32x4 t4 = *(const u32x4*)(Vtg + (size_t)row * vt_ld + kt * 64 + cc * 8); u32x2 lo2 = {t4.x, t4.y}, hi2 = {t4.z, t4.w}; *(u32x2*)(Vs + row * VLD + cc * 8) = lo2; *(u32x2*)(Vs + row * VLD + cc * 8 + 4) = hi2; }
      if (MODE == 3) mw = mrow[kt];
    }
    __syncthreads();
    if (PREF && kt + 1 < kt_hi) {
#pragma unroll
      for (int i = 0; i < 4; ++i) { int row = (tid >> 4) + i * 16, cc = tid & 15; pk[i] = *(const u32x4*)(Kg + (size_t)((kt + 1) * 64 + row) * DQK + cc * 8); }
      {
#pragma unroll
        for (int i = 0; i < 4; ++i) { int c = tid + i * 256, row = c >> 3, cc = c & 7; pv[i] = *(const u32x4*)(Vtg + (size_t)row * vt_ld + (kt + 1) * 64 + cc * 8); }
      }
      if (MODE == 3) mw_next = mrow[kt + 1];
    }
    bool tilebit = true;
    if (MODE == 2) tilebit = kt < 64 ? ((sel0 >> kt) & 1ull) : ((sel1 >> (kt - 64)) & 1ull);
    bool far = false;
    if (MODE == 4) far = (tmin_wave - (16 * (kt * 64 + 63) + 31)) >= 128;
    else if (MODE != 0) far = (tmin_wave - (kt * 64 + 63)) >= 128;
#pragma unroll
    for (int kb = 0; kb < 2; ++kb) {
      f32x16 st;
      compute_st<DQK>(Ks, kb, qf, Qs, l31, hh, st);
      __builtin_amdgcn_sched_barrier(0);
      const unsigned mb = (unsigned)(mw >> (32 * kb + 4 * hh));
      const int smax = kt * 64 + kb * 32 + 31, smin = kt * 64 + kb * 32;
      bool fast;
      if (MODE == 4) fast = (tmin_wave - (16 * smax + 31)) >= 128;
      else if (MODE == 0) fast = tmin_wave >= smax;
      else if (MODE == 1) fast = (tmin_wave - smax) >= 128 && (tmin_wave + 31 - smin) < 512;
      else fast = (tmin_wave - smax) >= 128;
      float mxs;
      if (fast) {
        float mx = NEG_INF;
#pragma unroll
        for (int r = 0; r < 16; ++r) {
          const int cr = (r & 3) + 8 * (r >> 2);
          float v = st[r];
          if (MODE == 3) v = ((mb >> cr) & 1u) ? v : NEG_INF;
          if (MODE == 2) v = tilebit ? v : NEG_INF;
          st[r] = v;
          mx = fmaxf(mx, v);
        }
        mxs = mx * scale2 + lutfar;
      } else {
        int dbase = (MODE == 4) ? (t - 31 - 16 * (kt * 64 + kb * 32 + 4 * hh)) : (t - 4 * hh - kt * 64 - kb * 32);
        asm volatile("" : "+v"(dbase));
        float mx = NEG_INF;
#pragma unroll
        for (int r = 0; r < 16; ++r) {
          const int cr = (r & 3) + 8 * (r >> 2);
          const int d0 = (MODE == 4) ? dbase - 16 * cr : dbase - cr;
          st[r] = mask_val<MODE>(st[r], d0, scale2, lut, far, lutfar, tilebit, mb, cr);
          mx = fmaxf(mx, st[r]);
        }
        mxs = mx;
      }
      mxs = xmax32(mxs);
      const float m_new = (mxs > m_run + 8.0f) ? mxs : m_run;
      const float m_use = (m_new == NEG_INF) ? 0.f : m_new;
      const float alpha = EXP2F(m_run - m_use);
      float rowsum = 0.f;
      if (fast) {
        const float c0 = lutfar - m_use;
#pragma unroll
        for (int r = 0; r < 16; ++r) { st[r] = EXP2F(__builtin_fmaf(st[r], scale2, c0)); rowsum += st[r]; }
      } else {
#pragma unroll
        for (int r = 0; r < 16; ++r) { st[r] = EXP2F(st[r] - m_use); rowsum += st[r]; }
      }
      l_run = l_run * alpha + rowsum;
      if (!__all(m_new == m_run)) {
#pragma unroll
        for (int i = 0; i < 4; ++i) {
#pragma unroll
          for (int r = 0; r < 16; ++r) o[i][r] *= alpha;
        }
      }
      m_run = m_new;
      __builtin_amdgcn_sched_barrier(0);
      __builtin_amdgcn_s_setprio(1);
#pragma unroll
      for (int s2 = 0; s2 < 2; ++s2) {
        u32x4 pw = {pack2(st[8 * s2], st[8 * s2 + 1]), pack2(st[8 * s2 + 2], st[8 * s2 + 3]),
                    pack2(st[8 * s2 + 4], st[8 * s2 + 5]), pack2(st[8 * s2 + 6], st[8 * s2 + 7])};
        bf16x8 pf = __builtin_bit_cast(bf16x8, pw);
#pragma unroll
        for (int dt = 0; dt < 4; ++dt) {
          const bf16_t* vp = Vs + (dt * 32 + l31) * VLD + kb * 32 + 16 * s2 + 4 * hh;
          s16x4 lo = *(const s16x4*)vp, hi = *(const s16x4*)(vp + 8);
          bf16x8 a = __builtin_shufflevector(lo, hi, 0, 1, 2, 3, 4, 5, 6, 7);
          o[dt] = MFMA_BF16(a, pf, o[dt]);
        }
      }
      __builtin_amdgcn_s_setprio(0);
      __builtin_amdgcn_sched_barrier(0);
    }
  }
  l_run = xsum32(l_run);
}

__device__ __forceinline__ void load_q(const bf16_t* Qrow, int hh, bf16x8 (&qf)[8]) {
#pragma unroll
  for (int ks = 0; ks < 8; ++ks) qf[ks] = *(const bf16x8*)(Qrow + ks * 16 + hh * 8);
}

__device__ __forceinline__ void build_lut(const Params& p, float* lut, int head) {
  if (TIDX < 129) lut[TIDX] = p.in[I_REL][t5_bucket(TIDX) * 16 + head] * LOG2E;
}

#define LUT_OFF 45056
#define IMP_OFF 46080
#define SCR_OFF 62592

__device__ __forceinline__ void phase_cmp_attn(const Params& p, unsigned char* smem) {
  unsigned char* ws = p.ws;
  const int tid = TIDX, lane = tid & 63, wave = tid >> 6, l31 = lane & 31, hh = lane >> 5;
  float* lut4 = (float*)(smem + LUT_OFF);
  float* imp = (float*)(smem + IMP_OFF);
  float* scr = (float*)(smem + SCR_OFF);
  float* lutw = (float*)(smem + SCR_OFF + 2048);
  (void)lut4;
  const float scale = 0.08838834764831845f;
  SNAKE_LOOP(it, 1024) {
    const int qt = 255 - (it >> 2), bg = it & 3, b = bg >> 1, g = bg & 1;
    const int q0 = qt * 32, t = q0 + l31, head = g * 4 + wave;
    __syncthreads();
    for (int e = tid; e < 4 * 129; e += 256) { int hd = e / 129, d = e % 129; lutw[e] = p.in[I_REL][t5_bucket(d) * 16 + g * 4 + hd] * LOG2E; }
    for (int e = tid; e < 32 * 129; e += 256) imp[e] = 0.f;
    __syncthreads();
    const float* lut = lutw + wave * 129;
    const bf16_t* Kg = (const bf16_t*)(ws + O_KCMP) + (size_t)bg * 512 * 128;
    const bf16_t* Vtg = (const bf16_t*)(ws + O_VCMPT) + (size_t)bg * 128 * 512;
    bf16x8 qf[8];
    load_q((const bf16_t*)(ws + O_QN) + ((size_t)(b * 8 + head) * 8192 + t) * 128, hh, qf);
    const int kt_hi = (q0 >> 10) + 1;
    f32x16 o[4]; float m_run, l_run;
    flash_loop<128, 4>(Kg, Vtg, 512, 0, kt_hi, qf, nullptr, t, q0, scale, lut, 0, 0, nullptr, smem, o, m_run, l_run);
    const float inv_l = l_run > 0.f ? 1.f / l_run : 0.f;
    {
      const float gc = ((const float*)(ws + O_GATES))[(size_t)(b * 8192 + t) * 24 + head * 3 + 0] * inv_l;
      float* oc = (float*)(ws + O_OC) + (size_t)(b * 8192 + t) * 1024 + head * 128;
#pragma unroll
      for (int dt = 0; dt < 4; ++dt)
#pragma unroll
        for (int rq = 0; rq < 4; ++rq) {
          float4 v = make_float4(o[dt][rq * 4] * gc, o[dt][rq * 4 + 1] * gc, o[dt][rq * 4 + 2] * gc, o[dt][rq * 4 + 3] * gc);
          *(float4*)(oc + dt * 32 + 8 * rq + 4 * hh) = v;
        }
    }
    bf16_t* Ks = (bf16_t*)smem;
    const float m_use = (m_run == NEG_INF) ? 0.f : m_run;
    for (int kt = 0; kt < kt_hi; ++kt) {
      __syncthreads();
#pragma unroll
      for (int i = 0; i < 4; ++i) { int c = tid + i * 256, row = c >> 4, cc = c & 15; *(u32x4*)(Ks + row * 136 + cc * 8) = *(const u32x4*)(Kg + (size_t)(kt * 64 + row) * 128 + cc * 8); }
      __syncthreads();
      const bool far = (q0 - (16 * (kt * 64 + 63) + 31)) >= 128;
      const float lutfar = lut[128];
      f32x16 st0, st1;
      compute_st<128>(Ks, 0, qf, nullptr, l31, hh, st0);
      compute_st<128>(Ks, 1, qf, nullptr, l31, hh, st1);
      int dbase = t - 31 - 16 * (kt * 64 + 4 * hh);
      asm volatile("" : "+v"(dbase));
#pragma unroll
      for (int r = 0; r < 16; ++r) {
        const int cr = (r & 3) + 8 * (r >> 2);
        st0[r] = EXP2F(mask_val<4>(st0[r], dbase - 16 * cr, scale * LOG2E, lut, far, lutfar, true, 0u, 0) - m_use) * inv_l;
        st1[r] = EXP2F(mask_val<4>(st1[r], dbase - 16 * cr - 512, scale * LOG2E, lut, far, lutfar, true, 0u, 0) - m_use) * inv_l;
      }
      for (int w = 0; w < 4; ++w) {
        if (wave == w) {
#pragma unroll
          for (int kb = 0; kb < 2; ++kb) {
#pragma unroll
            for (int rq = 0; rq < 4; ++rq) {
              float p0 = kb ? st1[rq * 4] : st0[rq * 4], p1 = kb ? st1[rq * 4 + 1] : st0[rq * 4 + 1];
              float p2 = kb ? st1[rq * 4 + 2] : st0[rq * 4 + 2], p3 = kb ? st1[rq * 4 + 3] : st0[rq * 4 + 3];
              int n = kt * 16 + kb * 8 + 2 * rq + hh;
              float mainv = p0 + p1 + p2 + 0.5f * p3;
              imp[l31 * 129 + n] += mainv;
              __builtin_amdgcn_s_waitcnt(0xc07f);
              imp[l31 * 129 + n + 1] += 0.5f * p3;
              __builtin_amdgcn_s_waitcnt(0xc07f);
            }
          }
        }
        __syncthreads();
      }
    }
    __syncthreads();
    for (int i = 0; i < 8; ++i) {
      const int q = wave * 8 + i, tq = q0 + q, tb = tq >> 6;
      float sc0, sc1;
      {
        int n = lane;
        bool forced = (n == 0) || (n == tb) || (n == tb - 1);
        sc0 = forced ? 1e9f : ((n * 64 <= tq) ? imp[q * 129 + n] : -1e30f);
        n = lane + 64;
        forced = (n == tb) || (n == tb - 1);
        sc1 = forced ? 1e9f : ((n * 64 <= tq) ? imp[q * 129 + n] : -1e30f);
      }
      scr[wave * 128 + lane] = sc0; scr[wave * 128 + 64 + lane] = sc1;
      __syncthreads();
      int rk0 = 0, rk1 = 0;
      for (int mI = 0; mI < 128; ++mI) {
        float v = scr[wave * 128 + mI];
        rk0 += (v > sc0) || (v == sc0 && mI < lane);
        rk1 += (v > sc1) || (v == sc1 && mI < lane + 64);
      }
      u64 w0 = __ballot(rk0 < 16), w1 = __ballot(rk1 < 16);
      if (lane == 0) {
        u64* sm = (u64*)(ws + O_SELM) + ((size_t)bg * 8192 + tq) * 2;
        sm[0] = w0; sm[1] = w1;
      }
      __syncthreads();
    }
  }
}

__device__ __forceinline__ void phase_attn0(const Params& p, unsigned char* smem) {
  unsigned char* ws = p.ws;
  const int tid = TIDX, lane = tid & 63, wave = tid >> 6, l31 = lane & 31, hh = lane >> 5;
  float* lut = (float*)(smem + LUT_OFF);
#pragma unroll 1
  SNAKE_LOOP(it, 1024) {
    const int qt = 63 - (it >> 4), sub = it & 15;
    const int q0 = qt * 128, t = q0 + wave * 32 + l31, tmin = q0 + wave * 32;
    {
      const int b = sub >> 3, head = sub & 7, g = head >> 2, bg = b * 2 + g;
      __syncthreads();
      build_lut(p, lut, head);
      __syncthreads();
      bf16x8 qf[8];
      load_q((const bf16_t*)(ws + O_QN) + ((size_t)(b * 8 + head) * 8192 + t) * 128, hh, qf);
      const float* gt = (const float*)(ws + O_GATES) + (size_t)(b * 8192 + t) * 24 + head * 3;
      float* oc = (float*)(ws + O_OC) + (size_t)(b * 8192 + t) * 1024 + head * 128;
      const float scale = 0.08838834764831845f;
      f32x16 o[4]; float m_run, l_run;
      {
        int lo = q0 - 511; if (lo < 0) lo = 0;
        flash_loop<128, 1>((const bf16_t*)(ws + O_KWIN) + (size_t)bg * 8192 * 128, (const bf16_t*)(ws + O_VWINT) + (size_t)bg * 128 * 8192, 8192,
                           lo >> 6, (q0 >> 6) + 2, qf, nullptr, t, tmin, scale, lut, 0, 0, nullptr, smem, o, m_run, l_run);
        const float gw = gt[2] * (l_run > 0.f ? 1.f / l_run : 0.f);
#pragma unroll
        for (int dt = 0; dt < 4; ++dt)
#pragma unroll
          for (int rq = 0; rq < 4; ++rq) {
            float4* pp = (float4*)(oc + dt * 32 + 8 * rq + 4 * hh);
            float4 v = *pp;
            v.x += o[dt][rq * 4] * gw; v.y += o[dt][rq * 4 + 1] * gw; v.z += o[dt][rq * 4 + 2] * gw; v.w += o[dt][rq * 4 + 3] * gw;
            *pp = v;
          }
      }
    }
  }
#pragma unroll 1
  SNAKE_LOOP(it, 1024) {
    const int qt = 63 - (it >> 4), sub = it & 15;
    const int q0 = qt * 128, t = q0 + wave * 32 + l31, tmin = q0 + wave * 32;
    {
      const int b = sub >> 3, head = sub & 7, g = head >> 2, bg = b * 2 + g;
      __syncthreads();
      build_lut(p, lut, head);
      __syncthreads();
      bf16x8 qf[8];
      load_q((const bf16_t*)(ws + O_QN) + ((size_t)(b * 8 + head) * 8192 + t) * 128, hh, qf);
      const float* gt = (const float*)(ws + O_GATES) + (size_t)(b * 8192 + t) * 24 + head * 3;
      const float* oc = (const float*)(ws + O_OC) + (size_t)(b * 8192 + t) * 1024 + head * 128;
      const float scale = 0.08838834764831845f;
      f32x16 o[4]; float m_run, l_run;
      {
        const u64* sm = (const u64*)(ws + O_SELM) + ((size_t)bg * 8192 + t) * 2;
        const u64 s0 = sm[0], s1 = sm[1];
        flash_loop<128, 2>((const bf16_t*)(ws + O_KSLC) + (size_t)bg * 8192 * 128, (const bf16_t*)(ws + O_VSLCT) + (size_t)bg * 128 * 8192, 8192,
                           0, (q0 >> 6) + 2, qf, nullptr, t, tmin, scale, lut, s0, s1, nullptr, smem, o, m_run, l_run);
        const float gs = gt[1] * (l_run > 0.f ? 1.f / l_run : 0.f);
        bf16_t* at = (bf16_t*)(ws + O_ATT0) + (size_t)(b * 8192 + t) * 2048 + head * 128;
#pragma unroll
        for (int dt = 0; dt < 4; ++dt)
#pragma unroll
          for (int rq = 0; rq < 4; ++rq) {
            float4 v = *(const float4*)(oc + dt * 32 + 8 * rq + 4 * hh);
            v.x += o[dt][rq * 4] * gs; v.y += o[dt][rq * 4 + 1] * gs; v.z += o[dt][rq * 4 + 2] * gs; v.w += o[dt][rq * 4 + 3] * gs;
            *(uint2*)(at + dt * 32 + 8 * rq + 4 * hh) = make_uint2(pack2(v.x, v.y), pack2(v.z, v.w));
          }
      }
    }
  }
#pragma unroll 1
  SNAKE_LOOP(it, 1024) {
    const int qt = 63 - (it >> 4), sub = it & 15;
    const int q0 = qt * 128, t = q0 + wave * 32 + l31, tmin = q0 + wave * 32;
    {
      const int s2 = sub, b = s2 >> 3, head = s2 & 7;
      bf16x8 qf[8];
      load_q((const bf16_t*)(ws + O_QMLA) + ((size_t)(b * 8 + head) * 8192 + t) * 192, hh, qf);
      bf16_t* Qsb = (bf16_t*)(smem + LUT_OFF);
      __syncthreads();
#pragma unroll
      for (int i = 0; i < 4; ++i) {
        int c = tid + i * 256, row = c >> 3, cc = c & 7;
        *(u32x4*)(Qsb + row * 72 + cc * 8) = *(const u32x4*)((const bf16_t*)(ws + O_QMLA) + ((size_t)(b * 8 + head) * 8192 + q0 + row) * 192 + 128 + cc * 8);
      }
      const bf16_t* Qs = Qsb + (wave * 32 + l31) * 72;
      f32x16 o[4]; float m_run, l_run;
      flash_loop<192, 0>((const bf16_t*)(ws + O_KMLA) + (size_t)(b * 8 + head) * 8192 * 192, (const bf16_t*)(ws + O_VMLAT) + (size_t)(b * 8 + head) * 128 * 8192, 8192,
                         0, (q0 >> 6) + 2, qf, Qs, t, tmin, 0.07216878364870322f, nullptr, 0, 0, nullptr, smem, o, m_run, l_run);
      const float il = l_run > 0.f ? 1.f / l_run : 0.f;
      bf16_t* at = (bf16_t*)(ws + O_ATT0) + (size_t)(b * 8192 + t) * 2048 + 1024 + head * 128;
#pragma unroll
      for (int dt = 0; dt < 4; ++dt)
#pragma unroll
        for (int rq = 0; rq < 4; ++rq)
          *(uint2*)(at + dt * 32 + 8 * rq + 4 * hh) = make_uint2(pack2(o[dt][rq * 4] * il, o[dt][rq * 4 + 1] * il), pack2(o[dt][rq * 4 + 2] * il, o[dt][rq * 4 + 3] * il));
    }
  }
}

__device__ __forceinline__ unsigned okey(float f) {
  unsigned u = __float_as_uint(f);
  return (u & 0x80000000u) ? ~u : (u | 0x80000000u);
}

__device__ __forceinline__ void phase_indexer(const Params& p, unsigned char* smem) {
  unsigned char* ws = p.ws;
  const int tid = TIDX, lane = tid & 63, wave = tid >> 6, l31 = lane & 31, hh = lane >> 5;
  _Float16* IQs = (_Float16*)smem;
  const _Float16* IQ = (const _Float16*)(ws + O_IQ);
  const _Float16* IK = (const _Float16*)(ws + O_IK);
  const float* IW = (const float*)(ws + O_IW);
  SNAKE_LOOP(it, 1024) {
    const int qt = 255 - (it >> 2), b = (it >> 1) & 1, kh = it & 1;
    const int q0 = qt * 32;
    float* scb = (float*)(ws + O_SC) + (size_t)b * SC_PERB + 1024ull * ((size_t)qt * (qt + 1) / 2);
    const int stride = 32 * (qt + 1);
    __syncthreads();
#pragma unroll
    for (int i = 0; i < 16; ++i) {
      int c = tid + i * 256, q = c >> 7, cc = c & 127;
      *(u32x4*)(IQs + q * 1032 + cc * 8) = *(const u32x4*)(IQ + ((size_t)(b * 8192 + q0 + q) * 1024 + cc * 8));
    }
    float* IWs = (float*)(smem + 66048);
    for (int e = tid; e < 512; e += 256) IWs[e] = IW[(size_t)(b * 8192 + q0) * 16 + e];
    __syncthreads();
    const int npairs = (qt + 2) >> 1;
    for (int pi = 2 * wave + kh; pi < npairs; pi += 8) {
      const int kb0 = 2 * pi, kb1 = 2 * pi + 1;
      f16x8 a0[4], a1[4];
#pragma unroll
      for (int ks = 0; ks < 4; ++ks) {
        a0[ks] = *(const f16x8*)(IK + ((size_t)(b * 8192 + kb0 * 32 + l31) * 64 + ks * 16 + hh * 8));
        a1[ks] = *(const f16x8*)(IK + ((size_t)(b * 8192 + kb1 * 32 + l31) * 64 + ks * 16 + hh * 8));
      }
      f32x16 tot0, tot1;
#pragma unroll
      for (int r = 0; r < 16; ++r) { tot0[r] = 0.f; tot1[r] = 0.f; }
#pragma unroll 1
      for (int hd = 0; hd < 16; ++hd) {
        f32x16 s0, s1;
#pragma unroll
        for (int r = 0; r < 16; ++r) { s0[r] = 0.f; s1[r] = 0.f; }
#pragma unroll
        for (int ks = 0; ks < 4; ++ks) {
          f16x8 bq = *(const f16x8*)(IQs + l31 * 1032 + hd * 64 + ks * 16 + hh * 8);
          s0 = MFMA_F16(a0[ks], bq, s0);
          s1 = MFMA_F16(a1[ks], bq, s1);
        }
        const float w = IWs[l31 * 16 + hd];
#pragma unroll
        for (int r = 0; r < 16; ++r) { tot0[r] += w * fmaxf(s0[r], 0.f); tot1[r] += w * fmaxf(s1[r], 0.f); }
      }
      float* rowp = scb + (size_t)l31 * stride;
#pragma unroll
      for (int rq = 0; rq < 4; ++rq) {
        *(float4*)(rowp + kb0 * 32 + 8 * rq + 4 * hh) = make_float4(tot0[rq * 4] + 0.f, tot0[rq * 4 + 1] + 0.f, tot0[rq * 4 + 2] + 0.f, tot0[rq * 4 + 3] + 0.f);
      }
      if (kb1 <= qt) {
#pragma unroll
        for (int rq = 0; rq < 4; ++rq) {
          *(float4*)(rowp + kb1 * 32 + 8 * rq + 4 * hh) = make_float4(tot1[rq * 4] + 0.f, tot1[rq * 4 + 1] + 0.f, tot1[rq * 4 + 2] + 0.f, tot1[rq * 4 + 3] + 0.f);
        }
      }
    }
  }
}

__device__ __forceinline__ void phase_select(const Params& p, unsigned char* smem) {
  unsigned char* ws = p.ws;
  const int tid = TIDX, lane = tid & 63, wave = tid >> 6;
  unsigned* hist = (unsigned*)smem + wave * 2112;
  unsigned* kl = (unsigned*)(smem + 36864) + wave * 1024 + lane;
#define KEY(w) ((w) < 16 ? kl[(w) * 64] : key[(w) - 16])
#pragma unroll 1
  SNAKE_LOOP(idx4, 4096) {
    const int idx = idx4 * 4 + wave;
    const int t = 8191 - (idx >> 1), b = idx & 1;
    const int qt = t >> 5, q = t & 31;
    const float* rowp = (const float*)(ws + O_SC) + (size_t)b * SC_PERB + 1024ull * ((size_t)qt * (qt + 1) / 2) + (size_t)q * (32 * (qt + 1));
    unsigned key[112];
#pragma unroll
    for (int w = 0; w < 128; ++w) {
      const int s = w * 64 + lane;
      const int scl = min(s, t);
      const unsigned kk = okey(rowp[scl]);
      const unsigned vm = 0u - (unsigned)min(max(t + 1 - s, 0), 1);
      if (w < 16) kl[w * 64] = kk & vm; else key[w - 16] = kk & vm;
    }
    asm volatile("s_waitcnt lgkmcnt(0)" ::: "memory");
    unsigned T = 0; int need = 0, eqc = 0;
    if (t + 1 > 256) {
      unsigned prefix = 0; int krem = 256;
#pragma unroll 1
      for (int pass = 0; pass < 3; ++pass) {
        const int shift = pass == 0 ? 21 : (pass == 1 ? 10 : 0);
        const int nbits = pass == 2 ? 10 : 11;
        const unsigned dmask = (1u << nbits) - 1u;
        unsigned klo = 1u, khi = 0xFFFFFFFFu;
        if (pass > 0) { klo = prefix << (shift + nbits); khi = klo | ((1u << (shift + nbits)) - 1u); if (klo == 0u) klo = 1u; }
        const unsigned span = khi - klo;
#pragma unroll
        for (int e = 0; e < 32; ++e) hist[e * 64 + lane] = 0;
        asm volatile("s_waitcnt lgkmcnt(0)" ::: "memory");
#pragma unroll
        for (int w = 0; w < 128; ++w) {
          const unsigned k = KEY(w);
          const unsigned d = k - klo;
          const unsigned nz = min(d - min(d, span), 1u);
          const unsigned fk = (k >> shift) & dmask;
          const unsigned bin = fk + nz * (2048u + (unsigned)lane - fk);
          atomicAdd(&hist[bin], 1u);
        }
        asm volatile("s_waitcnt lgkmcnt(0)" ::: "memory");
        unsigned local = 0;
#pragma unroll
        for (int j = 0; j < 32; ++j) local += hist[lane * 32 + j];
        unsigned incl = local;
#pragma unroll
        for (int o = 1; o < 64; o <<= 1) { unsigned v = __shfl_down(incl, o); if (lane + o < 64) incl += v; }
        const unsigned above = incl - local;
        const bool mine = ((int)above < krem) && ((int)(above + local) >= krem);
        unsigned dig = 0, kr = 0, hc = 0;
        if (mine) {
          unsigned acc = above; bool done = false;
#pragma unroll 1
          for (int j = 31; j >= 0; --j) {
            const unsigned h = hist[lane * 32 + j];
            if (!done && (int)(acc + h) >= krem) { dig = (unsigned)(lane * 32 + j); kr = (unsigned)(krem - (int)acc); hc = h; done = true; }
            acc += h;
          }
        }
        const int src = __ffsll((unsigned long long)__ballot(mine)) - 1;
        dig = (unsigned)__shfl((int)dig, src); kr = (unsigned)__shfl((int)kr, src); hc = (unsigned)__shfl((int)hc, src);
        prefix = (prefix << nbits) | dig;
        krem = (int)kr; eqc = (int)hc;
        asm volatile("s_waitcnt lgkmcnt(0)" ::: "memory");
      }
      T = prefix; need = krem;
    }
    u64* bm = (u64*)(ws + O_BITM) + (size_t)(b * 8192 + t) * 128;
    if (need == eqc) {
      unsigned v0lo = 0, v0hi = 0, v1lo = 0, v1hi = 0;
#pragma unroll
      for (int w = 0; w < 128; ++w) {
        const unsigned kw = KEY(w);
        const u64 word = __ballot(kw >= T && kw != 0u);
        const unsigned wl = (unsigned)word, wh = (unsigned)(word >> 32);
        if (w < 64) {
          asm volatile("s_nop 1\n\tv_writelane_b32 %0, %1, %2" : "+v"(v0lo) : "s"(wl), "n"(w & 63));
          asm volatile("v_writelane_b32 %0, %1, %2" : "+v"(v0hi) : "s"(wh), "n"(w & 63));
        } else {
          asm volatile("s_nop 1\n\tv_writelane_b32 %0, %1, %2" : "+v"(v1lo) : "s"(wl), "n"(w & 63));
          asm volatile("v_writelane_b32 %0, %1, %2" : "+v"(v1hi) : "s"(wh), "n"(w & 63));
        }
      }
      bm[lane] = ((u64)v0hi << 32) | v0lo; bm[64 + lane] = ((u64)v1hi << 32) | v1lo;
    } else {
      int base = 0;
#pragma unroll 1
      for (int w = 0; w < 128; ++w) {
        const int s = w * 64 + lane;
        unsigned k = 0;
        if (s <= t) k = okey(rowp[s]);
        const bool gt = (s <= t) && k > T;
        const bool eq = (s <= t) && k == T;
        const u64 eqm = __ballot(eq);
        const int rank = base + (int)__builtin_amdgcn_mbcnt_hi((unsigned)(eqm >> 32), __builtin_amdgcn_mbcnt_lo((unsigned)eqm, 0u));
        const u64 word = __ballot(gt || (eq && rank < need));
        base += __popcll(eqm);
        if (lane == 0) bm[w] = word;
      }
    }
  }
}

#undef KEY
__device__ __forceinline__ void phase_dsa_attn(const Params& p, unsigned char* smem) {
  unsigned char* ws = p.ws;
  const int tid = TIDX, lane = tid & 63, wave = tid >> 6, l31 = lane & 31, hh = lane >> 5;
  float* lut = (float*)(smem + LUT_OFF);
  SNAKE_LOOP(it, 2048) {
    const int qt = 63 - (it >> 5), sub = it & 31, b = sub >> 4, head = sub & 15, kvh = head >> 2;
    const int q0 = qt * 128, t = q0 + wave * 32 + l31, tmin = q0 + wave * 32;
    __syncthreads();
    build_lut(p, lut, head);
    __syncthreads();
    bf16x8 qf[8];
    load_q((const bf16_t*)(ws + O_QD) + ((size_t)(b * 16 + head) * 8192 + t) * 128, hh, qf);
    f32x16 o[4]; float m_run, l_run;
    flash_loop<128, 3>((const bf16_t*)(ws + O_KD) + (size_t)(b * 4 + kvh) * 8192 * 128, (const bf16_t*)(ws + O_VDT) + (size_t)(b * 4 + kvh) * 128 * 8192, 8192,
                       0, (q0 >> 6) + 2, qf, nullptr, t, tmin, 0.08838834764831845f, lut, 0, 0, (const u64*)(ws + O_BITM) + (size_t)(b * 8192 + t) * 128, smem, o, m_run, l_run);
    const float il = l_run > 0.f ? 1.f / l_run : 0.f;
    bf16_t* at = (bf16_t*)(ws + O_ATT1) + (size_t)(b * 8192 + t) * 2048 + head * 128;
#pragma unroll
    for (int dt = 0; dt < 4; ++dt)
#pragma unroll
      for (int rq = 0; rq < 4; ++rq)
        *(uint2*)(at + dt * 32 + 8 * rq + 4 * hh) = make_uint2(pack2(o[dt][rq * 4] * il, o[dt][rq * 4 + 1] * il), pack2(o[dt][rq * 4 + 2] * il, o[dt][rq * 4 + 3] * il));
  }
}

#define XB_TMO      128
#define XB_XCNT(j)  (256  + 64 * (j))
#define XB_XSUB(j)  (1280 + 64 * (j))
#define XB_XGEN(j)  (2304 + 64 * (j))
#define XB_TOP      3328
#define XB_TOPGEN   3392
#define XCD_BAR_WORDS 3456
#define XB_SPIN_CAP (1u << 25)
#define LAS __attribute__((address_space(3)))

__device__ __forceinline__ unsigned xb_ld(unsigned* p)              { return __hip_atomic_load(p, __ATOMIC_RELAXED, __HIP_MEMORY_SCOPE_AGENT); }
__device__ __forceinline__ unsigned xb_add(unsigned* p, unsigned v) { return __hip_atomic_fetch_add(p, v, __ATOMIC_RELAXED, __HIP_MEMORY_SCOPE_AGENT); }
__device__ __forceinline__ unsigned xb_xcc_id() { return (unsigned)__builtin_amdgcn_s_getreg((3 << 11) | 20) & 0xFu; }
#define XB_SPIN(cond, bar) do { unsigned _sp = 0; while (cond) { __builtin_amdgcn_s_sleep(1); \
    if ((++_sp & 255u) == 0u) { if (xb_ld(&(bar)[XB_TMO])) break; if (_sp > XB_SPIN_CAP) { atomicAdd(&(bar)[XB_TMO], 1u); break; } } } } while (0)

struct XcdBarrier {
    unsigned* bar; unsigned x;
    volatile LAS unsigned* st;
};

__device__ __forceinline__ XcdBarrier xcd_barrier_post(unsigned* bar, volatile LAS unsigned* st) {
    XcdBarrier b; b.bar = bar; b.x = xb_xcc_id(); b.st = st;
    if (TIDX == 0) (void)xb_add(&bar[XB_XCNT(b.x)], 1u);
    return b;
}
__device__ __forceinline__ void xcd_barrier_complete(unsigned* bar, unsigned x, unsigned& nloc, unsigned& nx) {
    const unsigned G = gridDim.x * gridDim.y * gridDim.z;
    unsigned sum, cnt, mine, sp = 0u;
    for (;;) {
        sum = 0u; cnt = 0u; mine = 0u;
#pragma unroll
        for (unsigned j = 0; j < 16; ++j) { const unsigned c = xb_ld(&bar[XB_XCNT(j)]); sum += c; cnt += (c > 0u) ? 1u : 0u; mine = (j == x) ? c : mine; }
        if (sum == G) break;
        __builtin_amdgcn_s_sleep(1);
        if ((++sp & 255u) == 0u) { if (xb_ld(&bar[XB_TMO])) break; if (sp > XB_SPIN_CAP) { atomicAdd(&bar[XB_TMO], 1u); break; } }
    }
    nloc = mine > 0u ? mine : 1u; nx = cnt > 0u ? cnt : 1u;
}

__device__ __forceinline__ void xcd_barrier(const XcdBarrier& b) {
    asm volatile("s_waitcnt vmcnt(0)" ::: "memory");
    __syncthreads();
    if (TIDX == 0) {
        unsigned* bar = b.bar;
        const unsigned bx = xb_xcc_id();
        __builtin_amdgcn_s_waitcnt(0);
        unsigned nloc = b.st[0], nx = b.st[1];
        if (nloc == 0u) { xcd_barrier_complete(bar, bx, nloc, nx); b.st[0] = nloc; b.st[1] = nx; }
        const unsigned old = xb_add(&bar[XB_XSUB(bx)], 1u);
        const unsigned gen = old / nloc;
        if (old + 1u == (gen + 1u) * nloc) {
            __builtin_amdgcn_fence(__ATOMIC_RELEASE, "agent");
            asm volatile("s_waitcnt vmcnt(0)" ::: "memory");
            const unsigned og = xb_add(&bar[XB_TOP], 1u);
            const unsigned tg = og / nx;
            if (og + 1u == (tg + 1u) * nx) xb_add(&bar[XB_TOPGEN], 1u);
            else XB_SPIN(xb_ld(&bar[XB_TOPGEN]) == tg, bar);
            __builtin_amdgcn_fence(__ATOMIC_ACQUIRE, "agent");
            xb_add(&bar[XB_XGEN(bx)], 1u);
            asm volatile("s_waitcnt vmcnt(0)" ::: "memory");
        } else {
            XB_SPIN(xb_ld(&bar[XB_XGEN(bx)]) == gen, bar);
            __builtin_amdgcn_fence(__ATOMIC_ACQUIRE, "agent");
            asm volatile("s_waitcnt vmcnt(0)" ::: "memory");
        }
    }
    __syncthreads();
}


#define NPHASES 20
#ifndef ONLY_PHASE
#define ONLY_PHASE -1
#endif
#define PH(n) (ONLY_PHASE < 0 || ONLY_PHASE == (n))
typedef const Params __attribute__((address_space(4))) * KParamsP;
__device__ __forceinline__ void get_params(Params& lp) {
  KParamsP pp = (KParamsP)__builtin_amdgcn_kernarg_segment_ptr();
  asm volatile("" : "+s"(pp));
#pragma unroll
  for (int i = 0; i < 27; ++i) lp.in[i] = pp->in[i];
  lp.out = pp->out; lp.ws = pp->ws; lp.ph_lo = 0; lp.ph_hi = 0;
}
#ifndef REPEAT_MASK
#define REPEAT_MASK 0
#endif
#define RUNPH(n, call) if (PH(n)) { Params p; get_params(p); unsigned char* ws = p.ws; (void)ws; call; if ((REPEAT_MASK >> (n)) & 1) { grid.sync(); call; } }

__global__ void __launch_bounds__(256, 2) mega(Params p_unused) {
  __shared__ __attribute__((aligned(16))) unsigned char smem[SMEM_BYTES];
  cg::grid_group grid = cg::this_grid();
  __shared__ uint4 xb_words;
  if (TIDX == 0) xb_words = make_uint4(0u, 0u, 0u, 0u);
  __syncthreads();
  XcdBarrier xb;
  { Params p; get_params(p); xb = xcd_barrier_post((unsigned*)(p.ws + O_BAR), (volatile LAS unsigned*)&xb_words); }
  RUNPH(0, phase_prep(p, smem))
  grid.sync();
  RUNPH(1, phase_reduce(p))
  xcd_barrier(xb);
#pragma unroll 1
  for (int L = 0; L < 2; ++L) {
    RUNPH(2, phase_norm(p, L == 0 ? p.in[I_X] : p.out, 2 * L))
    xcd_barrier(xb);
    if (L == 0) {
      RUNPH(3, phase_evin(p, smem))
      xcd_barrier(xb);
      RUNPH(4, phase_mid(p, smem))
      xcd_barrier(xb);
      RUNPH(5, phase_cmp2(p, smem))
      xcd_barrier(xb);
      RUNPH(6, phase_cmp_attn(p, smem))
      xcd_barrier(xb);
      RUNPH(7, phase_attn0(p, smem))
      xcd_barrier(xb);
    } else {
      RUNPH(13, phase_odin(p, smem))
      xcd_barrier(xb);
      RUNPH(14, phase_indexer(p, smem))
      xcd_barrier(xb);
      RUNPH(16, phase_select(p, smem))
      xcd_barrier(xb);
      RUNPH(15, phase_dsa_attn(p, smem))
      xcd_barrier(xb);
    }
    RUNPH(8, phase_resid(p, (const bf16_t*)(ws + (L == 0 ? O_ATT0 : O_ATT1)), 2048, (const bf16_t*)(ws + (L == 0 ? O_WEVOUT : O_WODOUT)),
                         L == 0 ? p.in[I_X] : p.out, p.out, 2 * L, smem))
    xcd_barrier(xb);
    RUNPH(2, phase_norm(p, p.out, 2 * L + 1))
    xcd_barrier(xb);
    RUNPH(10, phase_ffn_up(p, L, smem))
    xcd_barrier(xb);
    RUNPH(8, phase_resid(p, (const bf16_t*)(ws + O_ACT), 4096, (const bf16_t*)(ws + O_WDOWN) + (size_t)L * 2048 * 4096, p.out, p.out, 2 * L + 1, smem))
    if (L == 0) xcd_barrier(xb);
  }
}

extern "C" void kernel_launch(void* const* d_in, const int* in_sizes, int n_in, void* d_out, int out_size, void* d_ws, size_t ws_size,
                              hipStream_t stream) {
  static int grid_blocks = 0;
  if (!grid_blocks) {
    int dev = 0, cus = 0, per_cu = 0;
    hipGetDevice(&dev);
    hipDeviceGetAttribute(&cus, hipDeviceAttributeMultiprocessorCount, dev);
    hipOccupancyMaxActiveBlocksPerMultiprocessor(&per_cu, mega, 256, 0);
    if (per_cu < 1) per_cu = 1;
    if (per_cu > 2) per_cu = 2;
    grid_blocks = cus * per_cu;
    if (n_in != 27 || ws_size < WS_NEED) {
      fprintf(stderr, "kernel_launch: need %zu bytes of workspace, got %zu (n_in %d)\n", (size_t)WS_NEED, ws_size, n_in);
      grid_blocks = -1;
    }
  }
  if (grid_blocks < 0) return;
  (void)hipMemsetAsync((unsigned char*)d_ws + O_BAR, 0, XCD_BAR_WORDS * sizeof(unsigned), stream);
  Params p{};
  for (int i = 0; i < 27; ++i) p.in[i] = (const float*)d_in[i];
  p.out = (float*)d_out;
  p.ws = (unsigned char*)d_ws;
  p.ph_lo = 0; p.ph_hi = NPHASES;
  void* args[] = {&p};
  hipError_t e = hipLaunchCooperativeKernel((void*)mega, dim3(grid_blocks), dim3(256), args, 0, stream);
  if (e != hipSuccess) fprintf(stderr, "cooperative launch failed: %s (grid %d)\n", hipGetErrorString(e), grid_blocks);
}
```

```cpp
#include <hip/hip_runtime.h>
#include <hip/hip_cooperative_groups.h>
#include <stdint.h>
#include <stdio.h>
namespace cg = cooperative_groups;

typedef unsigned short bf16_t;
typedef unsigned long long u64;
typedef __attribute__((ext_vector_type(8))) short bf16x8;
typedef __attribute__((ext_vector_type(8))) _Float16 f16x8;
typedef __attribute__((ext_vector_type(16))) float f32x16;
typedef __attribute__((ext_vector_type(4))) unsigned u32x4;
typedef __attribute__((ext_vector_type(2))) unsigned u32x2;
typedef __attribute__((ext_vector_type(4))) float f32x4;
typedef __attribute__((ext_vector_type(4))) short s16x4;

#define SEQ 8192
#define NTOK 16384
#define DM 2048
#define EPSF 1e-6f
#define NEG_INF (-__builtin_inff())

constexpr size_t AL(size_t x) { return (x + 255) & ~size_t(255); }
constexpr size_t O_WEVIN  = 0;
constexpr size_t O_WEVOUT = O_WEVIN  + AL(3456ull * 2048 * 2);
constexpr size_t O_WCW1   = O_WEVOUT + AL(2048ull * 2048 * 2);
constexpr size_t O_WCW2   = O_WCW1   + AL(2ull * 256 * 4096 * 2);
constexpr size_t O_WUQ    = O_WCW2   + AL(2ull * 128 * 256 * 2);
constexpr size_t O_WUKV   = O_WUQ    + AL(1536ull * 512 * 2);
constexpr size_t O_WODIN  = O_WUKV   + AL(2048ull * 256 * 2);
constexpr size_t O_WODOUT = O_WODIN  + AL(4224ull * 2048 * 2);
constexpr size_t O_WUP    = O_WODOUT + AL(2048ull * 2048 * 2);
constexpr size_t O_WDOWN  = O_WUP    + AL(2ull * 8192 * 2048 * 2);
constexpr size_t O_ADAP   = O_WDOWN  + AL(2ull * 2048 * 4096 * 2);
constexpr size_t O_ADAM   = O_ADAP   + AL(4ull * 32 * 2 * 6144 * 4);
constexpr size_t O_CB1PART= O_ADAM   + AL(4ull * 2 * 6144 * 4);
constexpr size_t O_CB1P   = O_CB1PART+ AL(2ull * 16 * 256 * 4);
constexpr size_t O_ROPE64 = O_CB1P   + AL(2ull * 256 * 4);
constexpr size_t O_ROPE32 = O_ROPE64 + AL(2ull * 8192 * 32 * 4);
constexpr size_t O_H      = O_ROPE32 + AL(2ull * 8192 * 16 * 4);
constexpr size_t O_REG    = O_H      + AL(16384ull * 2048 * 2);
constexpr size_t O_QN     = O_REG;
constexpr size_t O_KSLC   = O_QN     + AL(16384ull * 1024 * 2);
constexpr size_t O_KWIN   = O_KSLC   + AL(16384ull * 256 * 2);
constexpr size_t O_VSLCT  = O_KWIN   + AL(16384ull * 256 * 2);
constexpr size_t O_VWINT  = O_VSLCT  + AL(16384ull * 256 * 2);
constexpr size_t O_KVSRC  = O_VWINT  + AL(16384ull * 256 * 2);
constexpr size_t O_HID    = O_KVSRC  + AL(8ull * 8192 * 128 * 2 + 65536);
constexpr size_t O_KCMP   = O_HID    + AL(8ull * 512 * 256 * 2);
constexpr size_t O_VCMPT  = O_KCMP   + AL(4ull * 512 * 128 * 2);
constexpr size_t O_CQ     = O_VCMPT  + AL(4ull * 512 * 128 * 2);
constexpr size_t O_CKV    = O_CQ     + AL(16384ull * 512 * 2);
constexpr size_t O_SSQ    = O_CKV    + AL(16384ull * 256 * 2);
constexpr size_t O_GATES  = O_SSQ    + AL(16384ull * 8 * 4);
constexpr size_t O_QMLA   = O_GATES  + AL(16384ull * 24 * 4);
constexpr size_t O_KMLA   = O_QMLA   + AL(16384ull * 8 * 192 * 2);
constexpr size_t O_VMLAT  = O_KMLA   + AL(16384ull * 8 * 192 * 2);
constexpr size_t O_OC     = O_VMLAT  + AL(16384ull * 1024 * 2);
constexpr size_t O_SELM   = O_OC     + AL(16384ull * 1024 * 4);
constexpr size_t O_ATT0   = O_SELM   + AL(4ull * 8192 * 16);
constexpr size_t O_L0END  = O_ATT0   + AL(16384ull * 2048 * 2);
constexpr size_t O_QD     = O_REG;
constexpr size_t O_KD     = O_QD     + AL(16384ull * 2048 * 2);
constexpr size_t O_VDT    = O_KD     + AL(16384ull * 512 * 2);
constexpr size_t O_IQ     = O_VDT    + AL(16384ull * 512 * 2);
constexpr size_t O_IK     = O_IQ     + AL(16384ull * 1024 * 2);
constexpr size_t O_IW     = O_IK     + AL(16384ull * 64 * 2 + 65536);
constexpr size_t O_BITM   = O_IW     + AL(16384ull * 16 * 4);
constexpr size_t O_SC     = O_BITM   + AL(16384ull * 128 * 8);
constexpr size_t SC_PERB  = 1024ull * (256ull * 257 / 2);
constexpr size_t O_ATT1   = O_SC;
constexpr size_t O_L1END  = O_SC     + AL(2ull * SC_PERB * 4);
constexpr size_t O_ACT    = O_REG;
constexpr size_t O_ACTEND = O_ACT    + AL(16384ull * 4096 * 2);
constexpr size_t cmax(size_t a, size_t b) { return a > b ? a : b; }
constexpr size_t O_BAR    = cmax(cmax(O_L0END, O_L1END), O_ACTEND);
constexpr size_t WS_NEED  = O_BAR + 16384;

struct Params {
  const float* in[27];
  float* out;
  unsigned char* ws;
  int ph_lo, ph_hi;
};
enum { I_X = 0, I_C, I_REL, I_ADAW, I_ADAB, I_NORMG, I_EVIN, I_EVOUT, I_NSAG, I_CPE, I_CW1, I_CB1, I_CW2, I_CB2,
       I_MQG, I_MKVG, I_WUQ, I_WUKV, I_NOPEG, I_ROPEG, I_ODIN, I_ODOUT, I_DSAG, I_FUP, I_FCW, I_FCB, I_FDOWN };

#define SMEM_BYTES 68608

__device__ __forceinline__ int tidx_() { int t = threadIdx.x; asm volatile("" : "+v"(t)); return t; }
#define TIDX tidx_()
#define SNAKE_LOOP(it, n) for (int _r = 0, it = blockIdx.x; _r * (int)gridDim.x < (n); ++_r, it = _r * gridDim.x + ((_r & 1) ? (gridDim.x - 1 - blockIdx.x) : blockIdx.x)) if (it < (n))
__device__ __forceinline__ unsigned short f2bf(float f) {
  unsigned u = __float_as_uint(f);
  u += 0x7fffu + ((u >> 16) & 1u);
  return (unsigned short)(u >> 16);
}
typedef __attribute__((ext_vector_type(2))) float f32x2_t;
typedef __attribute__((ext_vector_type(2))) __bf16 bf16x2_t;
__device__ __forceinline__ unsigned pack2(float a, float b) {
  f32x2_t v = {a, b};
  bf16x2_t r = __builtin_convertvector(v, bf16x2_t);
  return __builtin_bit_cast(unsigned, r);
}
#define EXP2F(x) __builtin_amdgcn_exp2f(x)
__device__ __forceinline__ float xmax32(float v) {
  auto r = __builtin_amdgcn_permlane32_swap(__float_as_uint(v), __float_as_uint(v), false, false);
  return fmaxf(__uint_as_float(r[0]), __uint_as_float(r[1]));
}
__device__ __forceinline__ float xsum32(float v) {
  auto r = __builtin_amdgcn_permlane32_swap(__float_as_uint(v), __float_as_uint(v), false, false);
  return __uint_as_float(r[0]) + __uint_as_float(r[1]);
}
#define LOG2E 1.4426950408889634f
__device__ __forceinline__ float dpp_row_sum(float v) {
  v += __uint_as_float(__builtin_amdgcn_update_dpp(0u, __float_as_uint(v), 0xB1, 0xF, 0xF, true));
  v += __uint_as_float(__builtin_amdgcn_update_dpp(0u, __float_as_uint(v), 0x4E, 0xF, 0xF, true));
  v += __uint_as_float(__builtin_amdgcn_update_dpp(0u, __float_as_uint(v), 0x141, 0xF, 0xF, true));
  v += __uint_as_float(__builtin_amdgcn_update_dpp(0u, __float_as_uint(v), 0x140, 0xF, 0xF, true));
  return v;
}
__device__ __forceinline__ float half_sum(float v) {
  v = dpp_row_sum(v);
  return v + __shfl_xor(v, 16);
}
__device__ __forceinline__ float wave_sum(float v) {
  v = half_sum(v);
  auto r = __builtin_amdgcn_permlane32_swap(__float_as_uint(v), __float_as_uint(v), false, false);
  return __uint_as_float(r[0]) + __uint_as_float(r[1]);
}
__device__ __forceinline__ float sigmoidf_(float x) { return 1.f / (1.f + __expf(-x)); }
__device__ __forceinline__ float siluf_(float x) { return x / (1.f + __expf(-x)); }
__device__ __forceinline__ float geluf_(float x) {
  float u = 0.7978845608028654f * (x + 0.044715f * x * x * x);
  float e = __expf(2.f * u);
  float th = 1.f - 2.f / (e + 1.f);
  return 0.5f * x * (1.f + th);
}
__device__ __forceinline__ int t5_bucket(int n) {
  if (n < 16) return n < 0 ? 0 : n;
  float v = logf((float)n / 16.f) / 2.0794415416798357f * 16.f;
  int l = 16 + (int)v;
  return l > 31 ? 31 : l;
}
#define MFMA_BF16(a, b, c) __builtin_amdgcn_mfma_f32_32x32x16_bf16((a), (b), (c), 0, 0, 0)
#define MFMA_F16(a, b, c) __builtin_amdgcn_mfma_f32_32x32x16_f16((a), (b), (c), 0, 0, 0)

__device__ __forceinline__ int src_col(int job, int n) {
  switch (job) {
    case 0:
      if (n < 2560) return n;
      if (n < 3072) return 2584 + (n - 2560);
      if (n < 3328) return 3096 + (n - 3072);
      if (n < 3392) return 3352 + (n - 3328);
      if (n < 3416) return 2560 + (n - 3392);
      return -1;
    case 6:
      if (n < 1024) return (n >> 7) * 192 + (n & 127);
      return ((n - 1024) >> 6) * 192 + 128 + ((n - 1024) & 63);
    case 8:
      return n < 4176 ? n : -1;
    case 10: case 11: {
      int tl = n >> 7, w = n & 127;
      return w < 64 ? tl * 64 + w : 4096 + tl * 64 + (w - 64);
    }
    default: return n;
  }
}

struct WTile { const float* src; bf16_t* dst; const float* rs; int K, N, n0, k0, c; };
__device__ __forceinline__ void decode_wtile(const Params& p, int it, WTile& w) {
  int t = it, job;
  if (t < 1728) job = 0;
  else if ((t -= 1728) < 1024) job = 1;
  else if ((t -= 1024) < 256) job = 2;
  else if ((t -= 256) < 256) job = 3;
  else if ((t -= 256) < 8) job = 4;
  else if ((t -= 8) < 8) job = 5;
  else if ((t -= 8) < 192) job = 6;
  else if ((t -= 192) < 128) job = 7;
  else if ((t -= 128) < 2112) job = 8;
  else if ((t -= 2112) < 1024) job = 9;
  else if ((t -= 1024) < 4096) job = 10;
  else if ((t -= 4096) < 4096) job = 11;
  else if ((t -= 4096) < 2048) job = 12;
  else { t -= 2048; job = 13; }
  const float* src; bf16_t* dst; int K, N, NP; const float* rs = nullptr;
  unsigned char* ws = p.ws;
  switch (job) {
    case 0: src = p.in[I_EVIN]; dst = (bf16_t*)(ws + O_WEVIN); K = 2048; N = 3416; NP = 3456; break;
    case 1: src = p.in[I_EVOUT]; dst = (bf16_t*)(ws + O_WEVOUT); K = 2048; N = 2048; NP = 2048; break;
    case 2: src = p.in[I_CW1]; dst = (bf16_t*)(ws + O_WCW1); K = 4096; N = 256; NP = 256; break;
    case 3: src = p.in[I_CW1] + 4096 * 256; dst = (bf16_t*)(ws + O_WCW1) + 256 * 4096; K = 4096; N = 256; NP = 256; break;
    case 4: src = p.in[I_CW2]; dst = (bf16_t*)(ws + O_WCW2); K = 256; N = 128; NP = 128; break;
    case 5: src = p.in[I_CW2] + 256 * 128; dst = (bf16_t*)(ws + O_WCW2) + 128 * 256; K = 256; N = 128; NP = 128; break;
    case 6: src = p.in[I_WUQ]; dst = (bf16_t*)(ws + O_WUQ); K = 512; N = 1536; NP = 1536; rs = p.in[I_MQG]; break;
    case 7: src = p.in[I_WUKV]; dst = (bf16_t*)(ws + O_WUKV); K = 256; N = 2048; NP = 2048; rs = p.in[I_MKVG]; break;
    case 8: src = p.in[I_ODIN]; dst = (bf16_t*)(ws + O_WODIN); K = 2048; N = 4176; NP = 4224; break;
    case 9: src = p.in[I_ODOUT]; dst = (bf16_t*)(ws + O_WODOUT); K = 2048; N = 2048; NP = 2048; break;
    case 10: src = p.in[I_FUP]; dst = (bf16_t*)(ws + O_WUP); K = 2048; N = 8192; NP = 8192; break;
    case 11: src = p.in[I_FUP] + 2048ull * 8192; dst = (bf16_t*)(ws + O_WUP) + 8192ull * 2048; K = 2048; N = 8192; NP = 8192; break;
    case 12: src = p.in[I_FDOWN]; dst = (bf16_t*)(ws + O_WDOWN); K = 4096; N = 2048; NP = 2048; break;
    default: src = p.in[I_FDOWN] + 4096ull * 2048; dst = (bf16_t*)(ws + O_WDOWN) + 2048ull * 4096; K = 4096; N = 2048; NP = 2048; break;
  }
  (void)NP;
  const int ktiles = K >> 6;
  w.src = src; w.dst = dst; w.rs = rs; w.K = K; w.N = N;
  w.n0 = (t / ktiles) << 6; w.k0 = (t % ktiles) << 6;
  w.c = src_col(job, w.n0 + 4 * (TIDX & 15));
}
__device__ __forceinline__ void wtile_load(const WTile& w, float4 (&v)[4]) {
  const int tid = TIDX, cc = w.c >= 0 ? w.c : 0;
#pragma unroll
  for (int i = 0; i < 4; ++i) v[i] = *(const float4*)(w.src + (size_t)(w.k0 + (tid >> 4) + 16 * i) * w.N + cc);
}
__device__ __forceinline__ void wtile_to_lds(const WTile& w, const float4 (&v)[4], float* tl) {
  const int tid = TIDX, n4 = tid & 15;
#pragma unroll
  for (int i = 0; i < 4; ++i) {
    const int k = (tid >> 4) + 16 * i;
    float sc = (w.c >= 0) ? 1.f : 0.f;
    if (w.rs) sc *= w.rs[w.k0 + k];
    tl[k * 65 + 4 * n4 + 0] = v[i].x * sc; tl[k * 65 + 4 * n4 + 1] = v[i].y * sc;
    tl[k * 65 + 4 * n4 + 2] = v[i].z * sc; tl[k * 65 + 4 * n4 + 3] = v[i].w * sc;
  }
}
__device__ __forceinline__ void wtile_store(const WTile& w, const float* tl) {
  const int tid = TIDX, n = tid >> 2, kc = tid & 3;
  unsigned x[8];
#pragma unroll
  for (int j = 0; j < 8; ++j) x[j] = pack2(tl[(kc * 16 + 2 * j) * 65 + n], tl[(kc * 16 + 2 * j + 1) * 65 + n]);
  uint4* d = (uint4*)(w.dst + (size_t)(w.n0 + n) * w.K + w.k0 + kc * 16);
  d[0] = make_uint4(x[0], x[1], x[2], x[3]);
  d[1] = make_uint4(x[4], x[5], x[6], x[7]);
}

#define NW_TILES 19024
#define NADA_ITEMS 768
#define NCB1_ITEMS 32
#define NROPE_ITEMS 1536

__device__ __forceinline__ void phase_prep(const Params& p, unsigned char* smem) {
  const int total = NW_TILES + NADA_ITEMS + NCB1_ITEMS + NROPE_ITEMS;
  const int tid = TIDX;
#pragma unroll 1
  for (int it = blockIdx.x; it < NW_TILES; it += 2 * gridDim.x) {
    float* tl0 = (float*)smem; float* tl1 = tl0 + 64 * 65;
    const bool two = (it + (int)gridDim.x) < NW_TILES;
    WTile wa, wb;
    decode_wtile(p, it, wa);
    decode_wtile(p, two ? it + (int)gridDim.x : it, wb);
    float4 va[4], vb[4];
    wtile_load(wa, va);
    wtile_load(wb, vb);
    wtile_to_lds(wa, va, tl0);
    wtile_to_lds(wb, vb, tl1);
    __syncthreads();
    wtile_store(wa, tl0);
    if (two) wtile_store(wb, tl1);
    __syncthreads();
  }
  for (int it = NW_TILES + blockIdx.x; it < total; it += gridDim.x) {
    if (false) {
    } else if (it < NW_TILES + NADA_ITEMS) {
      int a = it - NW_TILES;
      int kc = a & 31; int cc = (a >> 5) % 6; int mat = a / (32 * 6);
      float* sc = (float*)smem;
      if (tid < 128) { int b = tid >> 6, k = tid & 63; sc[tid] = siluf_(p.in[I_C][b * 2048 + kc * 64 + k]); }
      __syncthreads();
      const float* W = p.in[I_ADAW] + (size_t)mat * 2048 * 6144 + (size_t)(kc * 64) * 6144 + cc * 1024 + tid * 4;
      float4 a0 = make_float4(0.f, 0.f, 0.f, 0.f), a1 = a0;
#pragma unroll 8
      for (int k = 0; k < 64; ++k) {
        float4 w = *(const float4*)(W + (size_t)k * 6144);
        float s0 = sc[k], s1 = sc[64 + k];
        a0.x += s0 * w.x; a0.y += s0 * w.y; a0.z += s0 * w.z; a0.w += s0 * w.w;
        a1.x += s1 * w.x; a1.y += s1 * w.y; a1.z += s1 * w.z; a1.w += s1 * w.w;
      }
      float* part = (float*)(p.ws + O_ADAP);
      *(float4*)(part + ((size_t)(mat * 32 + kc) * 2 + 0) * 6144 + cc * 1024 + tid * 4) = a0;
      *(float4*)(part + ((size_t)(mat * 32 + kc) * 2 + 1) * 6144 + cc * 1024 + tid * 4) = a1;
      __syncthreads();
    } else if (it < NW_TILES + NADA_ITEMS + NCB1_ITEMS) {
      int a = it - NW_TILES - NADA_ITEMS;
      int j = a >> 4, kc = a & 15;
      const float* pe = p.in[I_CPE] + j * 4096 + kc * 256;
      const float* W = p.in[I_CW1] + (size_t)j * 4096 * 256 + (size_t)(kc * 256) * 256 + tid;
      float acc = 0.f;
#pragma unroll 8
      for (int k = 0; k < 256; ++k) acc += pe[k] * W[(size_t)k * 256];
      ((float*)(p.ws + O_CB1PART))[(j * 16 + kc) * 256 + tid] = acc;
    } else {
      int a = it - NW_TILES - NADA_ITEMS - NCB1_ITEMS;
      int e = a * 256 + tid;
      int t = e / 48, i = e % 48;
      float inv; int half, fi;
      if (i < 32) { half = 32; fi = i; } else { half = 16; fi = i - 32; }
      inv = powf(10000.0f, -(float)fi / (float)half);
      float angf = (float)t * inv;
      double ad = (double)angf;
      double kk = rint(ad * 0.15915494309189535);
      float r = (float)(ad - kk * 6.283185307179586);
      float cs = __cosf(r), sn = __sinf(r);
      if (i < 32) {
        float* R = (float*)(p.ws + O_ROPE64);
        R[t * 32 + fi] = cs; R[8192 * 32 + t * 32 + fi] = sn;
      } else {
        float* R = (float*)(p.ws + O_ROPE32);
        R[t * 16 + fi] = cs; R[8192 * 16 + t * 16 + fi] = sn;
      }
    }
  }
}

__device__ __forceinline__ void phase_reduce(const Params& p) {
  const int gtid = blockIdx.x * blockDim.x + TIDX, gsz = gridDim.x * blockDim.x;
  const float* part = (const float*)(p.ws + O_ADAP);
  float* M = (float*)(p.ws + O_ADAM);
  for (int e = gtid; e < 4 * 2 * 6144; e += gsz) {
    int n = e % 6144; int b = (e / 6144) & 1; int mat = e / (2 * 6144);
    float s = p.in[I_ADAB][mat * 6144 + n];
    for (int kc = 0; kc < 32; ++kc) s += part[((size_t)(mat * 32 + kc) * 2 + b) * 6144 + n];
    M[e] = s;
  }
  const float* cp = (const float*)(p.ws + O_CB1PART);
  float* C = (float*)(p.ws + O_CB1P);
  for (int e = gtid; e < 512; e += gsz) {
    int j = e >> 8, c = e & 255;
    float s = p.in[I_CB1][e];
    for (int kc = 0; kc < 16; ++kc) s += cp[(j * 16 + kc) * 256 + c];
    C[e] = s;
  }
}

__device__ __forceinline__ void phase_norm(const Params& p, const float* X, int mat) {
  const int lane = TIDX & 63, wave = TIDX >> 6;
  const float* g = p.in[I_NORMG] + mat * 2048;
  const float* M = (const float*)(p.ws + O_ADAM) + (size_t)mat * 2 * 6144;
  bf16_t* H = (bf16_t*)(p.ws + O_H);
  const int stride = gridDim.x * 4;
  int row = blockIdx.x * 4 + wave;
  f32x4 vn[8];
  if (row < NTOK) {
#pragma unroll
    for (int i = 0; i < 8; ++i) vn[i] = *(const f32x4*)(X + (size_t)row * 2048 + (i * 64 + lane) * 4);
  }
#pragma unroll 1
  for (; row < NTOK; row += stride) {
    const int b = row >> 13;
    f32x4 v[8]; float ss = 0.f;
#pragma unroll
    for (int i = 0; i < 8; ++i) { v[i] = vn[i]; ss += v[i].x * v[i].x + v[i].y * v[i].y + v[i].z * v[i].z + v[i].w * v[i].w; }
    {
      const int rn = (row + stride < NTOK) ? row + stride : row;
#pragma unroll
      for (int i = 0; i < 8; ++i) vn[i] = *(const f32x4*)(X + (size_t)rn * 2048 + (i * 64 + lane) * 4);
    }
    ss = wave_sum(ss);
    const float rs = rsqrtf(ss * (1.f / 2048.f) + EPSF);
    const float* sh = M + b * 6144; const float* scl = sh + 2048;
#pragma unroll
    for (int i = 0; i < 8; ++i) {
      int c = (i * 64 + lane) * 4;
      float4 gg = *(const float4*)(g + c), s4 = *(const float4*)(scl + c), h4 = *(const float4*)(sh + c);
      float y0 = v[i].x * rs * gg.x * (1.f + s4.x) + h4.x;
      float y1 = v[i].y * rs * gg.y * (1.f + s4.y) + h4.y;
      float y2 = v[i].z * rs * gg.z * (1.f + s4.z) + h4.z;
      float y3 = v[i].w * rs * gg.w * (1.f + s4.w) + h4.w;
      *(uint2*)(H + (size_t)row * 2048 + c) = make_uint2(pack2(y0, y1), pack2(y2, y3));
    }
  }
}

__device__ __forceinline__ void gemm_core(const bf16_t* __restrict__ A, long lda, int rowA0, int rowLo, int rowHi,
                                          const bf16_t* __restrict__ Bt, long ldb, int K, unsigned char* smem) {
  bf16_t* As = (bf16_t*)smem; bf16_t* Bs = As + 128 * 64;
  float* Cs = (float*)smem;
  const int tid = TIDX, lane = tid & 63, wave = tid >> 6;
  const int wm = wave >> 1, wn = wave & 1, l31 = lane & 31, hh = lane >> 5;
  f32x16 acc[2][2];
#pragma unroll
  for (int i = 0; i < 2; ++i)
#pragma unroll
    for (int j = 0; j < 2; ++j)
#pragma unroll
      for (int r = 0; r < 16; ++r) acc[i][j][r] = 0.f;
  u32x4 ra0[4], rb0[4], ra1[4], rb1[4];
#define GLOAD(RA, RB, KOFF)                                                                                   \
  _Pragma("unroll") for (int i = 0; i < 4; ++i) {                                                             \
    int c = tid + i * 256, row = c >> 3, kc = c & 7; int rr = rowA0 + row;                                    \
    u32x4 va = {0u, 0u, 0u, 0u};                                                                              \
    if (rr >= rowLo && rr < rowHi) va = *(const u32x4*)(A + (long)rr * lda + (KOFF) + kc * 8);                \
    RA[i] = va;                                                                                               \
    RB[i] = *(const u32x4*)(Bt + (long)row * ldb + (KOFF) + kc * 8);                                          \
  }
#define LSTORE(RA, RB)                                                                                        \
  _Pragma("unroll") for (int i = 0; i < 4; ++i) {                                                             \
    int c = tid + i * 256, row = c >> 3, kc = c & 7;                                                          \
    *(u32x4*)(As + row * 64 + ((kc ^ ((row >> 1) & 7)) << 3)) = RA[i];                                        \
    *(u32x4*)(Bs + row * 64 + ((kc ^ ((row >> 1) & 7)) << 3)) = RB[i];                                        \
  }
#define KSTEP()                                                                                               \
  __builtin_amdgcn_s_setprio(1);                                                                              \
  _Pragma("unroll") for (int ks = 0; ks < 4; ++ks) {                                                          \
    const int sw = (((ks * 2 + hh) ^ ((l31 >> 1) & 7)) << 3);                                                 \
    bf16x8 a0 = *(const bf16x8*)(As + (wm * 64 + l31) * 64 + sw);                                             \
    bf16x8 a1 = *(const bf16x8*)(As + (wm * 64 + 32 + l31) * 64 + sw);                                        \
    bf16x8 b0 = *(const bf16x8*)(Bs + (wn * 64 + l31) * 64 + sw);                                             \
    bf16x8 b1 = *(const bf16x8*)(Bs + (wn * 64 + 32 + l31) * 64 + sw);                                        \
    acc[0][0] = MFMA_BF16(a0, b0, acc[0][0]);                                                                 \
    acc[0][1] = MFMA_BF16(a0, b1, acc[0][1]);                                                                 \
    acc[1][0] = MFMA_BF16(a1, b0, acc[1][0]);                                                                 \
    acc[1][1] = MFMA_BF16(a1, b1, acc[1][1]);                                                                 \
  }                                                                                                           \
  __builtin_amdgcn_s_setprio(0);
  GLOAD(ra0, rb0, 0)
  GLOAD(ra1, rb1, 64)
#pragma unroll 1
  for (int k0 = 0; k0 < K; k0 += 128) {
    LSTORE(ra0, rb0)
    __syncthreads();
    if (k0 + 128 < K) { GLOAD(ra0, rb0, k0 + 128) }
    KSTEP()
    __syncthreads();
    LSTORE(ra1, rb1)
    __syncthreads();
    if (k0 + 192 < K) { GLOAD(ra1, rb1, k0 + 192) }
    KSTEP()
    __syncthreads();
  }
#undef GLOAD
#undef LSTORE
#undef KSTEP
#pragma unroll
  for (int i = 0; i < 2; ++i)
#pragma unroll
    for (int j = 0; j < 2; ++j)
#pragma unroll
      for (int r = 0; r < 16; ++r) {
        int row = wm * 64 + i * 32 + (r & 3) + 8 * (r >> 2) + 4 * hh;
        int col = wn * 64 + j * 32 + l31;
        Cs[row * 129 + col] = acc[i][j][r];
      }
  __syncthreads();
}

__device__ __forceinline__ void gemm_core2(const bf16_t* __restrict__ A, long lda, int rowA0, int rowLo, int rowHi,
                                           const bf16_t* __restrict__ Bt, long ldb, int K, unsigned char* smem, f32x16 (&acc)[2][4]) {
  bf16_t* As = (bf16_t*)smem; bf16_t* Bs = As + 128 * 64;
  const int tid = TIDX, lane = tid & 63, wave = tid >> 6;
  const int wm = wave >> 1, wn = wave & 1, l31 = lane & 31, hh = lane >> 5;
#pragma unroll
  for (int i = 0; i < 2; ++i)
#pragma unroll
    for (int j = 0; j < 4; ++j)
#pragma unroll
      for (int r = 0; r < 16; ++r) acc[i][j][r] = 0.f;
  u32x4 ra[4], rb[8];
#define GLOAD2(KOFF)                                                                                          \
  _Pragma("unroll") for (int i = 0; i < 4; ++i) {                                                             \
    int c = tid + i * 256, row = c >> 3, kc = c & 7; int rr = rowA0 + row;                                    \
    u32x4 va = {0u, 0u, 0u, 0u};                                                                              \
    if (rr >= rowLo && rr < rowHi) va = *(const u32x4*)(A + (long)rr * lda + (KOFF) + kc * 8);                \
    ra[i] = va;                                                                                               \
  }                                                                                                           \
  _Pragma("unroll") for (int i = 0; i < 8; ++i) {                                                             \
    int c = tid + i * 256, row = c >> 3, kc = c & 7;                                                          \
    rb[i] = *(const u32x4*)(Bt + (long)row * ldb + (KOFF) + kc * 8);                                          \
  }
  GLOAD2(0)
#pragma unroll 1
  for (int k0 = 0; k0 < K; k0 += 64) {
#pragma unroll
    for (int i = 0; i < 4; ++i) {
      int c = tid + i * 256, row = c >> 3, kc = c & 7;
      *(u32x4*)(As + row * 64 + ((kc ^ ((row >> 1) & 7)) << 3)) = ra[i];
    }
#pragma unroll
    for (int i = 0; i < 8; ++i) {
      int c = tid + i * 256, row = c >> 3, kc = c & 7;
      *(u32x4*)(Bs + row * 64 + ((kc ^ ((row >> 1) & 7)) << 3)) = rb[i];
    }
    __syncthreads();
    if (k0 + 64 < K) { GLOAD2(k0 + 64) }
    __builtin_amdgcn_s_setprio(1);
#pragma unroll
    for (int ks = 0; ks < 4; ++ks) {
      const int sw = (((ks * 2 + hh) ^ ((l31 >> 1) & 7)) << 3);
      bf16x8 a0 = *(const bf16x8*)(As + (wm * 64 + l31) * 64 + sw);
      bf16x8 a1 = *(const bf16x8*)(As + (wm * 64 + 32 + l31) * 64 + sw);
#pragma unroll
      for (int j = 0; j < 4; ++j) {
        bf16x8 bj = *(const bf16x8*)(Bs + (wn * 128 + j * 32 + l31) * 64 + sw);
        acc[0][j] = MFMA_BF16(a0, bj, acc[0][j]);
        acc[1][j] = MFMA_BF16(a1, bj, acc[1][j]);
      }
    }
    __builtin_amdgcn_s_setprio(0);
    __syncthreads();
  }
#undef GLOAD2
}
__device__ __forceinline__ void stage_half(const f32x16 (&acc)[2][4], int h, float* Cs) {
  const int tid = TIDX, lane = tid & 63, wave = tid >> 6;
  const int wm = wave >> 1, wn = wave & 1, l31 = lane & 31, hh = lane >> 5;
  if (wn == h) {
#pragma unroll
    for (int i = 0; i < 2; ++i)
#pragma unroll
      for (int j = 0; j < 4; ++j)
#pragma unroll
        for (int r = 0; r < 16; ++r)
          Cs[(wm * 64 + i * 32 + (r & 3) + 8 * (r >> 2) + 4 * hh) * 129 + j * 32 + l31] = acc[i][j][r];
  }
  __syncthreads();
}

#define CSV(r, c) Cs[(r) * 129 + (c)]

__device__ __forceinline__ void epi_rms128(const float* Cs, const float* g, bf16_t* dst, long dst_ld, const float* rowscale) {
  const int lane = TIDX & 63, wave = TIDX >> 6;
  const float g0 = g[2 * lane], g1 = g[2 * lane + 1];
#pragma unroll 1
  for (int i = 0; i < 32; ++i) {
    int r = wave * 32 + i;
    float v0 = CSV(r, 2 * lane), v1 = CSV(r, 2 * lane + 1);
    if (rowscale) { float s = rowscale[r]; v0 *= s; v1 *= s; }
    float ss = wave_sum(v0 * v0 + v1 * v1);
    float rs = rsqrtf(ss * (1.f / 128.f) + EPSF);
    *(unsigned*)(dst + (long)r * dst_ld + 2 * lane) = pack2(v0 * rs * g0, v1 * rs * g1);
  }
}
__device__ __forceinline__ void epi_raw(const float* Cs, bf16_t* dst, long dst_ld) {
  const int lane = TIDX & 63, wave = TIDX >> 6;
#pragma unroll 1
  for (int i = 0; i < 32; ++i) {
    int r = wave * 32 + i;
    *(unsigned*)(dst + (long)r * dst_ld + 2 * lane) = pack2(CSV(r, 2 * lane), CSV(r, 2 * lane + 1));
  }
}
__device__ __forceinline__ void epi_transposed(const float* Cs, bf16_t* dst, long dst_ld, const float* rowscale) {
  const int lane = TIDX & 63, wave = TIDX >> 6;
  float s0 = 1.f, s1 = 1.f;
  if (rowscale) { s0 = rowscale[2 * lane]; s1 = rowscale[2 * lane + 1]; }
#pragma unroll 1
  for (int i = 0; i < 32; ++i) {
    int d = wave * 32 + i;
    *(unsigned*)(dst + (long)d * dst_ld + 2 * lane) = pack2(CSV(2 * lane, d) * s0, CSV(2 * lane + 1, d) * s1);
  }
}

__device__ __forceinline__ void evin_epi(const Params& p, float* Cs, int tm, int tn) {
  unsigned char* ws = p.ws;
  const int lane = TIDX & 63, wave = TIDX >> 6;
  const float* rope = (const float*)(ws + O_ROPE64);
    const int tok0 = tm * 128, b = tok0 >> 13, t0 = tok0 & 8191;
    if (tn < 8) {
      epi_rms128(Cs, p.in[I_NSAG], (bf16_t*)(ws + O_QN) + ((size_t)(b * 8 + tn) * 8192 + t0) * 128, 128, nullptr);
    } else if (tn < 20) {
      int idx = tn - 8, j = idx >> 1, g = idx & 1;
      if (j < 2) epi_raw(Cs, (bf16_t*)(ws + O_KVSRC) + ((size_t)((j * 2 + b) * 2 + g) * 8192 + t0) * 128, 128);
      else if (j == 2) epi_rms128(Cs, p.in[I_NSAG] + 128, (bf16_t*)(ws + O_KSLC) + ((size_t)(b * 2 + g) * 8192 + t0) * 128, 128, nullptr);
      else if (j == 4) epi_rms128(Cs, p.in[I_NSAG] + 128, (bf16_t*)(ws + O_KWIN) + ((size_t)(b * 2 + g) * 8192 + t0) * 128, 128, nullptr);
      else if (j == 3) epi_transposed(Cs, (bf16_t*)(ws + O_VSLCT) + (size_t)(b * 2 + g) * 128 * 8192 + t0, 8192, nullptr);
      else epi_transposed(Cs, (bf16_t*)(ws + O_VWINT) + (size_t)(b * 2 + g) * 128 * 8192 + t0, 8192, nullptr);
    } else if (tn < 26) {
      bf16_t* dst; int ld, slot;
      if (tn < 24) { dst = (bf16_t*)(ws + O_CQ) + (size_t)tok0 * 512 + (tn - 20) * 128; ld = 512; slot = tn - 20; }
      else { dst = (bf16_t*)(ws + O_CKV) + (size_t)tok0 * 256 + (tn - 24) * 128; ld = 256; slot = 4 + tn - 24; }
      float* ssq = (float*)(ws + O_SSQ);
    #pragma unroll 1
  for (int i = 0; i < 32; ++i) {
        int r = wave * 32 + i;
        float v0 = CSV(r, 2 * lane), v1 = CSV(r, 2 * lane + 1);
        float ss = wave_sum(v0 * v0 + v1 * v1);
        *(unsigned*)(dst + (long)r * ld + 2 * lane) = pack2(v0, v1);
        if (lane == 0) ssq[(size_t)(tok0 + r) * 8 + slot] = ss;
      }
    } else {
      const float* g = p.in[I_ROPEG] + 64;
      const int c0 = 2 * (lane & 31);
      const float g0 = g[c0], g1 = g[c0 + 1];
      bf16_t* kml = (bf16_t*)(ws + O_KMLA);
      float* gates = (float*)(ws + O_GATES);
      const int ci = c0 & 31;
      float2 csn = *(const float2*)(rope + (t0 + wave * 32) * 32 + ci), snn = *(const float2*)(rope + 8192 * 32 + (t0 + wave * 32) * 32 + ci);
    #pragma unroll 1
  for (int i = 0; i < 32; ++i) {
        int r = wave * 32 + i, t = t0 + r;
        float v0 = CSV(r, 2 * lane), v1 = CSV(r, 2 * lane + 1);
        float ss = half_sum(v0 * v0 + v1 * v1);
        float rs = rsqrtf(ss * (1.f / 64.f) + EPSF);
        float y0 = v0 * rs * g0, y1 = v1 * rs * g1;
        float q0 = __shfl_xor(y0, 16), q1 = __shfl_xor(y1, 16);
        const float2 cs = csn, sn = snn;
        { const int tnx = (i + 1 < 32) ? t + 1 : t; csn = *(const float2*)(rope + tnx * 32 + ci); snn = *(const float2*)(rope + 8192 * 32 + tnx * 32 + ci); }
        if (lane < 32) {
          float o0, o1;
          if (lane < 16) { o0 = y0 * cs.x - q0 * sn.x; o1 = y1 * cs.y - q1 * sn.y; }
          else { o0 = q0 * sn.x + y0 * cs.x; o1 = q1 * sn.y + y1 * cs.y; }
          unsigned pk = pack2(o0, o1);
#pragma unroll
          for (int hd = 0; hd < 8; ++hd) *(unsigned*)(kml + ((size_t)(b * 8 + hd) * 8192 + t) * 192 + 128 + c0) = pk;
        } else if (lane < 44) {
          int gi = 2 * (lane - 32);
          gates[(size_t)(tok0 + r) * 24 + gi] = sigmoidf_(v0);
          gates[(size_t)(tok0 + r) * 24 + gi + 1] = sigmoidf_(v1);
        }
      }
    }
}
__device__ __forceinline__ void phase_evin(const Params& p, unsigned char* smem) {
  unsigned char* ws = p.ws;
  float* Cs = (float*)smem;
#pragma unroll 1
  for (int it = blockIdx.x; it < 128 * 12; it += gridDim.x) {
    const int tn2 = it % 12, tm = it / 12;
    f32x16 acc[2][4];
    gemm_core2((const bf16_t*)(ws + O_H), 2048, tm * 128, 0, NTOK, (const bf16_t*)(ws + O_WEVIN) + (size_t)tn2 * 256 * 2048, 2048, 2048, smem, acc);
#pragma unroll 1
    for (int h = 0; h < 2; ++h) {
      stage_half(acc, h, Cs);
      evin_epi(p, Cs, tm, tn2 * 2 + h);
      __syncthreads();
    }
  }
#pragma unroll 1
  for (int it = blockIdx.x; it < 128 * 3; it += gridDim.x) {
    const int tn = 24 + it % 3, tm = it / 3;
    gemm_core((const bf16_t*)(ws + O_H), 2048, tm * 128, 0, NTOK, (const bf16_t*)(ws + O_WEVIN) + (size_t)tn * 128 * 2048, 2048, 2048, smem);
    evin_epi(p, Cs, tm, tn);
    __syncthreads();
  }
}

__device__ __forceinline__ void phase_mid(const Params& p, unsigned char* smem) {
  unsigned char* ws = p.ws;
  float* Cs = (float*)smem;
  float* rsc = (float*)(smem + 66048);
  const int lane = TIDX & 63, wave = TIDX >> 6;
  const int n_cmp = 64, n_uq = 128 * 12, n_ukv = 128 * 16;
  const float* rope = (const float*)(ws + O_ROPE64);
  const float* ssq = (const float*)(ws + O_SSQ);
#pragma unroll 1
  for (int it = blockIdx.x; it < n_cmp; it += gridDim.x) {
    {
      int pidx = it >> 3, tm = (it >> 1) & 3, tn = it & 1;
      int j = pidx >> 2;
      gemm_core((const bf16_t*)(ws + O_KVSRC) + (size_t)pidx * 8192 * 128, 2048, tm * 128, 0, 511,
                (const bf16_t*)(ws + O_WCW1) + (size_t)j * 256 * 4096 + (size_t)tn * 128 * 4096, 4096, 4096, smem);
      const float* cb = (const float*)(ws + O_CB1P) + j * 256 + tn * 128;
      bf16_t* hid = (bf16_t*)(ws + O_HID) + ((size_t)pidx * 512 + tm * 128) * 256 + tn * 128;
      const float b0 = cb[2 * lane], b1 = cb[2 * lane + 1];
    #pragma unroll 1
  for (int i = 0; i < 32; ++i) {
        int r = wave * 32 + i;
        *(unsigned*)(hid + (long)r * 256 + 2 * lane) = pack2(geluf_(CSV(r, 2 * lane) + b0), geluf_(CSV(r, 2 * lane + 1) + b1));
      }
    }
    __syncthreads();
  }
#pragma unroll 1
  for (int it = blockIdx.x; it < n_uq; it += gridDim.x) {
    {
      int a = it; int tn = a % 12, tm = a / 12;
      gemm_core((const bf16_t*)(ws + O_CQ), 512, tm * 128, 0, NTOK, (const bf16_t*)(ws + O_WUQ) + (size_t)tn * 128 * 512, 512, 512, smem);
      const int tok0 = tm * 128, b = tok0 >> 13, t0 = tok0 & 8191;
      if (TIDX < 128) {
        const float* s = ssq + (size_t)(tok0 + TIDX) * 8;
        rsc[TIDX] = rsqrtf((s[0] + s[1] + s[2] + s[3]) * (1.f / 512.f) + EPSF);
      }
      __syncthreads();
      bf16_t* qm = (bf16_t*)(ws + O_QMLA);
      if (tn < 8) {
        epi_rms128(Cs, p.in[I_NOPEG], qm + ((size_t)(b * 8 + tn) * 8192 + t0) * 192, 192, rsc);
      } else {
        const float* g = p.in[I_ROPEG];
        const int c0 = 2 * (lane & 31), hd = 2 * (tn - 8) + (lane >> 5), l31 = lane & 31;
        const float g0 = g[c0], g1 = g[c0 + 1];
        const int ci = c0 & 31;
        float2 csn = *(const float2*)(rope + (t0 + wave * 32) * 32 + ci), snn = *(const float2*)(rope + 8192 * 32 + (t0 + wave * 32) * 32 + ci);
      #pragma unroll 1
  for (int i = 0; i < 32; ++i) {
          int r = wave * 32 + i, t = t0 + r;
          float sc = rsc[r];
          float v0 = CSV(r, 2 * lane) * sc, v1 = CSV(r, 2 * lane + 1) * sc;
          float ss = half_sum(v0 * v0 + v1 * v1);
          float rs = rsqrtf(ss * (1.f / 64.f) + EPSF);
          float y0 = v0 * rs * g0, y1 = v1 * rs * g1;
          float q0 = __shfl_xor(y0, 16), q1 = __shfl_xor(y1, 16);
          const float2 cs = csn, sn = snn;
          { const int tnx = (i + 1 < 32) ? t + 1 : t; csn = *(const float2*)(rope + tnx * 32 + ci); snn = *(const float2*)(rope + 8192 * 32 + tnx * 32 + ci); }
          float o0, o1;
          if (l31 < 16) { o0 = y0 * cs.x - q0 * sn.x; o1 = y1 * cs.y - q1 * sn.y; }
          else { o0 = q0 * sn.x + y0 * cs.x; o1 = q1 * sn.y + y1 * cs.y; }
          *(unsigned*)(qm + ((size_t)(b * 8 + hd) * 8192 + t) * 192 + 128 + c0) = pack2(o0, o1);
        }
      }
    }
    __syncthreads();
  }
#pragma unroll 1
  for (int it = blockIdx.x; it < n_ukv; it += gridDim.x) {
    {
      int a = it; int tn = a & 15, tm = a >> 4;
      gemm_core((const bf16_t*)(ws + O_CKV), 256, tm * 128, 0, NTOK, (const bf16_t*)(ws + O_WUKV) + (size_t)tn * 128 * 256, 256, 256, smem);
      const int tok0 = tm * 128, b = tok0 >> 13, t0 = tok0 & 8191, hd = tn >> 1;
      if (TIDX < 128) {
        const float* s = ssq + (size_t)(tok0 + TIDX) * 8;
        rsc[TIDX] = rsqrtf((s[4] + s[5]) * (1.f / 256.f) + EPSF);
      }
      __syncthreads();
      if ((tn & 1) == 0) epi_rms128(Cs, p.in[I_NOPEG] + 128, (bf16_t*)(ws + O_KMLA) + ((size_t)(b * 8 + hd) * 8192 + t0) * 192, 192, rsc);
      else epi_transposed(Cs, (bf16_t*)(ws + O_VMLAT) + (size_t)(b * 8 + hd) * 128 * 8192 + t0, 8192, rsc);
    }
    __syncthreads();
  }
}

__device__ __forceinline__ void phase_cmp2(const Params& p, unsigned char* smem) {
  unsigned char* ws = p.ws;
  float* Cs = (float*)smem;
  const int lane = TIDX & 63, wave = TIDX >> 6;
  for (int it = blockIdx.x; it < 32; it += gridDim.x) {
    int pidx = it >> 2, tm = it & 3;
    int j = pidx >> 2, bg = pidx & 3;
    gemm_core((const bf16_t*)(ws + O_HID) + (size_t)pidx * 512 * 256, 256, tm * 128, 0, 512,
              (const bf16_t*)(ws + O_WCW2) + (size_t)j * 128 * 256, 256, 256, smem);
    const float* b2 = p.in[I_CB2] + j * 128;
  #pragma unroll 1
  for (int i = 0; i < 32; ++i) {
      int r = wave * 32 + i;
      CSV(r, 2 * lane) += b2[2 * lane]; CSV(r, 2 * lane + 1) += b2[2 * lane + 1];
    }
    __syncthreads();
    if (j == 0) epi_rms128(Cs, p.in[I_NSAG] + 128, (bf16_t*)(ws + O_KCMP) + ((size_t)bg * 512 + tm * 128) * 128, 128, nullptr);
    else epi_transposed(Cs, (bf16_t*)(ws + O_VCMPT) + (size_t)bg * 128 * 512 + tm * 128, 512, nullptr);
    __syncthreads();
  }
}

__device__ __forceinline__ void phase_resid(const Params& p, const bf16_t* A, int K, const bf16_t* Bt, const float* src, float* dst, int mat, unsigned char* smem) {
  float* Cs = (float*)smem;
  const int lane = TIDX & 63, wave = TIDX >> 6;
  const float* M = (const float*)(p.ws + O_ADAM) + (size_t)mat * 2 * 6144;
  for (int it = blockIdx.x; it < 128 * 8; it += gridDim.x) {
    const int tn2 = it & 7, tm = it >> 3;
    f32x16 acc[2][4];
    gemm_core2(A, K, tm * 128, 0, NTOK, Bt + (size_t)tn2 * 256 * K, K, K, smem, acc);
#pragma unroll 1
    for (int h = 0; h < 2; ++h) {
    stage_half(acc, h, Cs);
    const int tn = tn2 * 2 + h;
    const int tok0 = tm * 128, b = tok0 >> 13;
    const int col = tn * 128 + 2 * lane;
    const float g0 = M[b * 6144 + 4096 + col], g1 = M[b * 6144 + 4096 + col + 1];
#pragma unroll 1
    for (int i0 = 0; i0 < 32; i0 += 8) {
      f32x2_t sv[8];
#pragma unroll
      for (int j = 0; j < 8; ++j) sv[j] = *(const f32x2_t*)(src + (size_t)(tok0 + wave * 32 + i0 + j) * 2048 + col);
#pragma unroll
      for (int j = 0; j < 8; ++j) {
        const int r = wave * 32 + i0 + j;
        f32x2_t d = {sv[j].x + g0 * CSV(r, 2 * lane), sv[j].y + g1 * CSV(r, 2 * lane + 1)};
        *(f32x2_t*)(dst + (size_t)(tok0 + r) * 2048 + col) = d;
      }
    }
    __syncthreads();
    }
  }
}

__device__ __forceinline__ void phase_ffn_up(const Params& p, int layer, unsigned char* smem) {
  float* Cs = (float*)smem;
  const int lane = TIDX & 63, wave = TIDX >> 6;
  const bf16_t* Bt = (const bf16_t*)(p.ws + O_WUP) + (size_t)layer * 8192 * 2048;
  const float* cw = p.in[I_FCW] + (size_t)layer * 3 * 8192;
  const float* cb = p.in[I_FCB] + (size_t)layer * 8192;
  bf16_t* act = (bf16_t*)(p.ws + O_ACT);
  for (int it = blockIdx.x; it < 132 * 32; it += gridDim.x) {
    const int tn2 = it & 31, tmi = it >> 5;
    const int b = tmi / 66, i66 = tmi % 66;
    const int rowA0 = b * 8192 + i66 * 126 - 2;
    f32x16 acc[2][4];
    gemm_core2((const bf16_t*)(p.ws + O_H), 2048, rowA0, b * 8192, (b + 1) * 8192, Bt + (size_t)tn2 * 256 * 2048, 2048, 2048, smem, acc);
#pragma unroll 1
    for (int h = 0; h < 2; ++h) {
    stage_half(acc, h, Cs);
    const int tn = tn2 * 2 + h;
    const int cg_ = tn * 64 + lane, cv_ = 4096 + tn * 64 + lane;
    const float wg0 = cw[cg_], wg1 = cw[8192 + cg_], wg2 = cw[16384 + cg_], bg = cb[cg_];
    const float wv0 = cw[cv_], wv1 = cw[8192 + cv_], wv2 = cw[16384 + cv_], bv = cb[cv_];
  #pragma unroll 1
  for (int i = 0; i < 32; ++i) {
      int r = wave * 32 + i;
      if (r < 2) continue;
      int tok = rowA0 + r;
      if (tok >= (b + 1) * 8192) continue;
      float ug = wg0 * CSV(r - 2, lane) + wg1 * CSV(r - 1, lane) + wg2 * CSV(r, lane) + bg;
      float uv = wv0 * CSV(r - 2, 64 + lane) + wv1 * CSV(r - 1, 64 + lane) + wv2 * CSV(r, 64 + lane) + bv;
      act[(size_t)tok * 4096 + tn * 64 + lane] = (bf16_t)(pack2(siluf_(ug) * uv, 0.f) & 0xFFFFu);
    }
    __syncthreads();
    }
  }
}

__device__ __forceinline__ void odin_epi(const Params& p, float* Cs, int tm, int tn) {
  unsigned char* ws = p.ws;
  const int lane = TIDX & 63, wave = TIDX >> 6;
  const float* rope = (const float*)(ws + O_ROPE32);
    const int tok0 = tm * 128, b = tok0 >> 13, t0 = tok0 & 8191;
    if (tn < 16) {
      epi_rms128(Cs, p.in[I_DSAG], (bf16_t*)(ws + O_QD) + ((size_t)(b * 16 + tn) * 8192 + t0) * 128, 128, nullptr);
    } else if (tn < 20) {
      epi_rms128(Cs, p.in[I_DSAG] + 128, (bf16_t*)(ws + O_KD) + ((size_t)(b * 4 + tn - 16) * 8192 + t0) * 128, 128, nullptr);
    } else if (tn < 24) {
      epi_transposed(Cs, (bf16_t*)(ws + O_VDT) + (size_t)(b * 4 + tn - 20) * 128 * 8192 + t0, 8192, nullptr);
    } else {
      const int l31 = lane & 31, c0 = 2 * l31;
      _Float16* iq = (_Float16*)(ws + O_IQ);
      _Float16* ik = (_Float16*)(ws + O_IK);
      float* iw = (float*)(ws + O_IW);
      const int ci = c0 & 15;
      float2 csn = *(const float2*)(rope + (t0 + wave * 32) * 16 + ci), snn = *(const float2*)(rope + 8192 * 16 + (t0 + wave * 32) * 16 + ci);
    #pragma unroll 1
  for (int i = 0; i < 32; ++i) {
        int r = wave * 32 + i, t = t0 + r;
        float v0 = CSV(r, 2 * lane), v1 = CSV(r, 2 * lane + 1);
        float q0 = __shfl_xor(v0, 8), q1 = __shfl_xor(v1, 8);
        float o0 = v0, o1 = v1;
        const float2 cs = csn, sn = snn;
        { const int tnx = (i + 1 < 32) ? t + 1 : t; csn = *(const float2*)(rope + tnx * 16 + ci); snn = *(const float2*)(rope + 8192 * 16 + tnx * 16 + ci); }
        if (l31 < 8) { o0 = v0 * cs.x - q0 * sn.x; o1 = v1 * cs.y - q1 * sn.y; }
        else if (l31 < 16) { o0 = q0 * sn.x + v0 * cs.x; o1 = q1 * sn.y + v1 * cs.y; }
        if (tn < 32) {
          int ih = 2 * (tn - 24) + (lane >> 5);
          _Float16* d = iq + ((size_t)(tok0 + r) * 16 + ih) * 64 + c0;
          d[0] = (_Float16)(o0 * 0.125f); d[1] = (_Float16)(o1 * 0.125f);
        } else if (lane < 32) {
          _Float16* d = ik + (size_t)(tok0 + r) * 64 + c0;
          d[0] = (_Float16)o0; d[1] = (_Float16)o1;
        } else if (lane < 40) {
          int wi = 2 * (lane - 32);
          iw[(size_t)(tok0 + r) * 16 + wi] = v0 * 0.25f;
          iw[(size_t)(tok0 + r) * 16 + wi + 1] = v1 * 0.25f;
        }
      }
    }
}
__device__ __forceinline__ void phase_odin(const Params& p, unsigned char* smem) {
  unsigned char* ws = p.ws;
  float* Cs = (float*)smem;
#pragma unroll 1
  for (int it = blockIdx.x; it < 128 * 16; it += gridDim.x) {
    const int tn2 = it & 15, tm = it >> 4;
    f32x16 acc[2][4];
    gemm_core2((const bf16_t*)(ws + O_H), 2048, tm * 128, 0, NTOK, (const bf16_t*)(ws + O_WODIN) + (size_t)tn2 * 256 * 2048, 2048, 2048, smem, acc);
#pragma unroll 1
    for (int h = 0; h < 2; ++h) {
      stage_half(acc, h, Cs);
      odin_epi(p, Cs, tm, tn2 * 2 + h);
      __syncthreads();
    }
  }
#pragma unroll 1
  for (int tm = blockIdx.x; tm < 128; tm += gridDim.x) {
    gemm_core((const bf16_t*)(ws + O_H), 2048, tm * 128, 0, NTOK, (const bf16_t*)(ws + O_WODIN) + (size_t)32 * 128 * 2048, 2048, 2048, smem);
    odin_epi(p, Cs, tm, 32);
    __syncthreads();
  }
}

template <int DQK>
__device__ __forceinline__ void compute_st(const bf16_t* Ks, int kb, const bf16x8 (&qf)[8], const bf16_t* Qs, int l31, int hh, f32x16& st) {
#pragma unroll
  for (int r = 0; r < 16; ++r) st[r] = 0.f;
  __builtin_amdgcn_s_setprio(1);
#pragma unroll
  for (int ks = 0; ks < DQK / 16; ++ks) {
    bf16x8 a0 = *(const bf16x8*)(Ks + (kb * 32 + l31) * (DQK + 8) + ks * 16 + hh * 8);
    bf16x8 bq;
    if (ks < 8) bq = qf[ks < 8 ? ks : 0];
    else bq = *(const bf16x8*)(Qs + (ks - 8) * 16 + hh * 8);
    st = MFMA_BF16(a0, bq, st);
  }
  __builtin_amdgcn_s_setprio(0);
}

template <int MODE>
__device__ __forceinline__ float mask_val(float sraw, int d, float scale, const float* lut, bool far, float lutfar, bool tilebit, unsigned mw, int bitpos) {
  bool ok = d >= 0;
  if (MODE == 1) ok = ok && d < 512;
  if (MODE == 2) ok = ok && tilebit;
  if (MODE == 3) ok = ok && ((mw >> bitpos) & 1u);
  float bias = 0.f;
  if (MODE != 0) {
    if (far) bias = lutfar;
    else { int di = d < 0 ? 0 : (d > 128 ? 128 : d); bias = lut[di]; }
  }
  return ok ? sraw * scale + bias : NEG_INF;
}

template <int DQK, int MODE>
__device__ __forceinline__ void flash_loop(const bf16_t* __restrict__ Kg, const bf16_t* __restrict__ Vtg, int vt_ld, int kt_lo, int kt_hi,
                                           const bf16x8 (&qf)[8], const bf16_t* Qs, int t, int tmin_wave, float scale, const float* lut,
                                           u64 sel0, u64 sel1, const u64* mrow, unsigned char* smem,
                                           f32x16 (&o)[4], float& m_run, float& l_run) {
  constexpr int LDK = DQK + 8, KCH = DQK / 8, NKC = 64 * KCH / 256;
  bf16_t* Ks = (bf16_t*)smem; bf16_t* Vs = Ks + 64 * LDK;
  constexpr int VLD = 68;
  const int tid = TIDX, lane = tid & 63, l31 = lane & 31, hh = lane >> 5;
  const float lutfar = (MODE != 0) ? lut[128] : 0.f;
  const float scale2 = scale * LOG2E;
#pragma unroll
  for (int i = 0; i < 4; ++i) {
#pragma unroll
    for (int r = 0; r < 16; ++r) o[i][r] = 0.f;
  }
  m_run = NEG_INF; l_run = 0.f;
  constexpr bool PREF = (MODE != 4);
  u32x4 pk[4], pv[4];
  u64 mw_next = 0;
  if (PREF && kt_lo < kt_hi) {
#pragma unroll
    for (int i = 0; i < 4; ++i) { int row = (tid >> 4) + i * 16, cc = tid & 15; pk[i] = *(const u32x4*)(Kg + (size_t)(kt_lo * 64 + row) * DQK + cc * 8); }
    {
#pragma unroll
      for (int i = 0; i < 4; ++i) { int c = tid + i * 256, row = c >> 3, cc = c & 7; pv[i] = *(const u32x4*)(Vtg + (size_t)row * vt_ld + kt_lo * 64 + cc * 8); }
    }
    if (MODE == 3) mw_next = mrow[kt_lo];
  }
#pragma unroll 1
  for (int kt = kt_lo; kt < kt_hi; ++kt) {
    __syncthreads();
    u64 mw = 0;
    if (PREF) {
#pragma unroll
      for (int i = 0; i < 4; ++i) { int row = (tid >> 4) + i * 16, cc = tid & 15; *(u32x4*)(Ks + row * LDK + cc * 8) = pk[i]; }
      if (DQK > 128) {
#pragma unroll
        for (int i = 0; i < 2; ++i) { int row = (tid >> 3) + i * 32, cc = 16 + (tid & 7); *(u32x4*)(Ks + row * LDK + cc * 8) = *(const u32x4*)(Kg + (size_t)(kt * 64 + row) * DQK + cc * 8); }
      }
      {
#pragma unroll
        for (int i = 0; i < 4; ++i) { int c = tid + i * 256, row = c >> 3, cc = c & 7; u32x2 lo2 = {pv[i].x, pv[i].y}, hi2 = {pv[i].z, pv[i].w}; *(u32x2*)(Vs + row * VLD + cc * 8) = lo2; *(u32x2*)(Vs + row * VLD + cc * 8 + 4) = hi2; }
      }
      mw = mw_next;
    } else {
#pragma unroll
      for (int i = 0; i < 4; ++i) { int row = (tid >> 4) + i * 16, cc = tid & 15; *(u32x4*)(Ks + row * LDK + cc * 8) = *(const u32x4*)(Kg + (size_t)(kt * 64 + row) * DQK + cc * 8); }
      if (DQK > 128) {
#pragma unroll
        for (int i = 0; i < 2; ++i) { int row = (tid >> 3) + i * 32, cc = 16 + (tid & 7); *(u32x4*)(Ks + row * LDK + cc * 8) = *(const u32x4*)(Kg + (size_t)(kt * 64 + row) * DQK + cc * 8); }
      }
#pragma unroll
      for (int i = 0; i < 4; ++i) { int c = tid + i * 256, row = c >> 3, cc = c & 7; const u32x4 t4 = *(const u32x4*)(Vtg + (size_t)row * vt_ld + kt * 64 + cc * 8); u32x2 lo2 = {t4.x, t4.y}, hi2 = {t4.z, t4.w}; *(u32x2*)(Vs + row * VLD + cc * 8) = lo2; *(u32x2*)(Vs + row * VLD + cc * 8 + 4) = hi2; }
      if (MODE == 3) mw = mrow[kt];
    }
    __syncthreads();
    if (PREF && kt + 1 < kt_hi) {
#pragma unroll
      for (int i = 0; i < 4; ++i) { int row = (tid >> 4) + i * 16, cc = tid & 15; pk[i] = *(const u32x4*)(Kg + (size_t)((kt + 1) * 64 + row) * DQK + cc * 8); }
      {
#pragma unroll
        for (int i = 0; i < 4; ++i) { int c = tid + i * 256, row = c >> 3, cc = c & 7; pv[i] = *(const u32x4*)(Vtg + (size_t)row * vt_ld + (kt + 1) * 64 + cc * 8); }
      }
      if (MODE == 3) mw_next = mrow[kt + 1];
    }
    bool tilebit = true;
    if (MODE == 2) tilebit = kt < 64 ? ((sel0 >> kt) & 1ull) : ((sel1 >> (kt - 64)) & 1ull);
    bool far = false;
    if (MODE == 4) far = (tmin_wave - (16 * (kt * 64 + 63) + 31)) >= 128;
    else if (MODE != 0) far = (tmin_wave - (kt * 64 + 63)) >= 128;
#pragma unroll
    for (int kb = 0; kb < 2; ++kb) {
      f32x16 st;
      compute_st<DQK>(Ks, kb, qf, Qs, l31, hh, st);
      __builtin_amdgcn_sched_barrier(0);
      const unsigned mb = (unsigned)(mw >> (32 * kb + 4 * hh));
      const int smax = kt * 64 + kb * 32 + 31, smin = kt * 64 + kb * 32;
      bool fast;
      if (MODE == 4) fast = (tmin_wave - (16 * smax + 31)) >= 128;
      else if (MODE == 0) fast = tmin_wave >= smax;
      else if (MODE == 1) fast = (tmin_wave - smax) >= 128 && (tmin_wave + 31 - smin) < 512;
      else fast = (tmin_wave - smax) >= 128;
      float mxs;
      if (fast) {
        float mx = NEG_INF;
#pragma unroll
        for (int r = 0; r < 16; ++r) {
          const int cr = (r & 3) + 8 * (r >> 2);
          float v = st[r];
          if (MODE == 3) v = ((mb >> cr) & 1u) ? v : NEG_INF;
          if (MODE == 2) v = tilebit ? v : NEG_INF;
          st[r] = v;
          mx = fmaxf(mx, v);
        }
        mxs = mx * scale2 + lutfar;
      } else {
        int dbase = (MODE == 4) ? (t - 31 - 16 * (kt * 64 + kb * 32 + 4 * hh)) : (t - 4 * hh - kt * 64 - kb * 32);
        asm volatile("" : "+v"(dbase));
        float mx = NEG_INF;
#pragma unroll
        for (int r = 0; r < 16; ++r) {
          const int cr = (r & 3) + 8 * (r >> 2);
          const int d0 = (MODE == 4) ? dbase - 16 * cr : dbase - cr;
          st[r] = mask_val<MODE>(st[r], d0, scale2, lut, far, lutfar, tilebit, mb, cr);
          mx = fmaxf(mx, st[r]);
        }
        mxs = mx;
      }
      mxs = xmax32(mxs);
      const float m_new = (mxs > m_run + 8.0f) ? mxs : m_run;
      const float m_use = (m_new == NEG_INF) ? 0.f : m_new;
      const float alpha = EXP2F(m_run - m_use);
      float rowsum = 0.f;
      if (fast) {
        const float c0 = lutfar - m_use;
#pragma unroll
        for (int r = 0; r < 16; ++r) { st[r] = EXP2F(__builtin_fmaf(st[r], scale2, c0)); rowsum += st[r]; }
      } else {
#pragma unroll
        for (int r = 0; r < 16; ++r) { st[r] = EXP2F(st[r] - m_use); rowsum += st[r]; }
      }
      l_run = l_run * alpha + rowsum;
      if (!__all(m_new == m_run)) {
#pragma unroll
        for (int i = 0; i < 4; ++i) {
#pragma unroll
          for (int r = 0; r < 16; ++r) o[i][r] *= alpha;
        }
      }
      m_run = m_new;
      __builtin_amdgcn_sched_barrier(0);
      __builtin_amdgcn_s_setprio(1);
#pragma unroll
      for (int s2 = 0; s2 < 2; ++s2) {
        u32x4 pw = {pack2(st[8 * s2], st[8 * s2 + 1]), pack2(st[8 * s2 + 2], st[8 * s2 + 3]),
                    pack2(st[8 * s2 + 4], st[8 * s2 + 5]), pack2(st[8 * s2 + 6], st[8 * s2 + 7])};
        bf16x8 pf = __builtin_bit_cast(bf16x8, pw);
#pragma unroll
        for (int dt = 0; dt < 4; ++dt) {
          const bf16_t* vp = Vs + (dt * 32 + l31) * VLD + kb * 32 + 16 * s2 + 4 * hh;
          s16x4 lo = *(const s16x4*)vp, hi = *(const s16x4*)(vp + 8);
          bf16x8 a = __builtin_shufflevector(lo, hi, 0, 1, 2, 3, 4, 5, 6, 7);
          o[dt] = MFMA_BF16(a, pf, o[dt]);
        }
      }
      __builtin_amdgcn_s_setprio(0);
      __builtin_amdgcn_sched_barrier(0);
    }
  }
  l_run = xsum32(l_run);
}

__device__ __forceinline__ void load_q(const bf16_t* Qrow, int hh, bf16x8 (&qf)[8]) {
#pragma unroll
  for (int ks = 0; ks < 8; ++ks) qf[ks] = *(const bf16x8*)(Qrow + ks * 16 + hh * 8);
}

__device__ __forceinline__ void build_lut(const Params& p, float* lut, int head) {
  if (TIDX < 129) lut[TIDX] = p.in[I_REL][t5_bucket(TIDX) * 16 + head] * LOG2E;
}

#define LUT_OFF 45056
#define IMP_OFF 46080
#define SCR_OFF 62592

__device__ __forceinline__ void phase_cmp_attn(const Params& p, unsigned char* smem) {
  unsigned char* ws = p.ws;
  const int tid = TIDX, lane = tid & 63, wave = tid >> 6, l31 = lane & 31, hh = lane >> 5;
  float* lut4 = (float*)(smem + LUT_OFF);
  float* imp = (float*)(smem + IMP_OFF);
  float* scr = (float*)(smem + SCR_OFF);
  float* lutw = (float*)(smem + SCR_OFF + 2048);
  (void)lut4;
  const float scale = 0.08838834764831845f;
  SNAKE_LOOP(it, 1024) {
    const int qt = 255 - (it >> 2), bg = it & 3, b = bg >> 1, g = bg & 1;
    const int q0 = qt * 32, t = q0 + l31, head = g * 4 + wave;
    __syncthreads();
    for (int e = tid; e < 4 * 129; e += 256) { int hd = e / 129, d = e % 129; lutw[e] = p.in[I_REL][t5_bucket(d) * 16 + g * 4 + hd] * LOG2E; }
    for (int e = tid; e < 32 * 129; e += 256) imp[e] = 0.f;
    __syncthreads();
    const float* lut = lutw + wave * 129;
    const bf16_t* Kg = (const bf16_t*)(ws + O_KCMP) + (size_t)bg * 512 * 128;
    const bf16_t* Vtg = (const bf16_t*)(ws + O_VCMPT) + (size_t)bg * 128 * 512;
    bf16x8 qf[8];
    load_q((const bf16_t*)(ws + O_QN) + ((size_t)(b * 8 + head) * 8192 + t) * 128, hh, qf);
    const int kt_hi = (q0 >> 10) + 1;
    f32x16 o[4]; float m_run, l_run;
    flash_loop<128, 4>(Kg, Vtg, 512, 0, kt_hi, qf, nullptr, t, q0, scale, lut, 0, 0, nullptr, smem, o, m_run, l_run);
    const float inv_l = l_run > 0.f ? 1.f / l_run : 0.f;
    {
      const float gc = ((const float*)(ws + O_GATES))[(size_t)(b * 8192 + t) * 24 + head * 3 + 0] * inv_l;
      float* oc = (float*)(ws + O_OC) + (size_t)(b * 8192 + t) * 1024 + head * 128;
#pragma unroll
      for (int dt = 0; dt < 4; ++dt)
#pragma unroll
        for (int rq = 0; rq < 4; ++rq) {
          float4 v = make_float4(o[dt][rq * 4] * gc, o[dt][rq * 4 + 1] * gc, o[dt][rq * 4 + 2] * gc, o[dt][rq * 4 + 3] * gc);
          *(float4*)(oc + dt * 32 + 8 * rq + 4 * hh) = v;
        }
    }
    bf16_t* Ks = (bf16_t*)smem;
    const float m_use = (m_run == NEG_INF) ? 0.f : m_run;
    for (int kt = 0; kt < kt_hi; ++kt) {
      __syncthreads();
#pragma unroll
      for (int i = 0; i < 4; ++i) { int c = tid + i * 256, row = c >> 4, cc = c & 15; *(u32x4*)(Ks + row * 136 + cc * 8) = *(const u32x4*)(Kg + (size_t)(kt * 64 + row) * 128 + cc * 8); }
      __syncthreads();
      const bool far = (q0 - (16 * (kt * 64 + 63) + 31)) >= 128;
      const float lutfar = lut[128];
      f32x16 st0, st1;
      compute_st<128>(Ks, 0, qf, nullptr, l31, hh, st0);
      compute_st<128>(Ks, 1, qf, nullptr, l31, hh, st1);
      int dbase = t - 31 - 16 * (kt * 64 + 4 * hh);
      asm volatile("" : "+v"(dbase));
#pragma unroll
      for (int r = 0; r < 16; ++r) {
        const int cr = (r & 3) + 8 * (r >> 2);
        st0[r] = EXP2F(mask_val<4>(st0[r], dbase - 16 * cr, scale * LOG2E, lut, far, lutfar, true, 0u, 0) - m_use) * inv_l;
        st1[r] = EXP2F(mask_val<4>(st1[r], dbase - 16 * cr - 512, scale * LOG2E, lut, far, lutfar, true, 0u, 0) - m_use) * inv_l;
      }
      for (int w = 0; w < 4; ++w) {
        if (wave == w) {
#pragma unroll
          for (int kb = 0; kb < 2; ++kb) {
#pragma unroll
            for (int rq = 0; rq < 4; ++rq) {
              float p0 = kb ? st1[rq * 4] : st0[rq * 4], p1 = kb ? st1[rq * 4 + 1] : st0[rq * 4 + 1];
              float p2 = kb ? st1[rq * 4 + 2] : st0[rq * 4 + 2], p3 = kb ? st1[rq * 4 + 3] : st0[rq * 4 + 3];
              int n = kt * 16 + kb * 8 + 2 * rq + hh;
              float mainv = p0 + p1 + p2 + 0.5f * p3;
              imp[l31 * 129 + n] += mainv;
              __builtin_amdgcn_s_waitcnt(0xc07f);
              imp[l31 * 129 + n + 1] += 0.5f * p3;
              __builtin_amdgcn_s_waitcnt(0xc07f);
            }
          }
        }
        __syncthreads();
      }
    }
    __syncthreads();
    for (int i = 0; i < 8; ++i) {
      const int q = wave * 8 + i, tq = q0 + q, tb = tq >> 6;
      float sc0, sc1;
      {
        int n = lane;
        bool forced = (n == 0) || (n == tb) || (n == tb - 1);
        sc0 = forced ? 1e9f : ((n * 64 <= tq) ? imp[q * 129 + n] : -1e30f);
        n = lane + 64;
        forced = (n == tb) || (n == tb - 1);
        sc1 = forced ? 1e9f : ((n * 64 <= tq) ? imp[q * 129 + n] : -1e30f);
      }
      scr[wave * 128 + lane] = sc0; scr[wave * 128 + 64 + lane] = sc1;
      __syncthreads();
      int rk0 = 0, rk1 = 0;
      for (int mI = 0; mI < 128; ++mI) {
        float v = scr[wave * 128 + mI];
        rk0 += (v > sc0) || (v == sc0 && mI < lane);
        rk1 += (v > sc1) || (v == sc1 && mI < lane + 64);
      }
      u64 w0 = __ballot(rk0 < 16), w1 = __ballot(rk1 < 16);
      if (lane == 0) {
        u64* sm = (u64*)(ws + O_SELM) + ((size_t)bg * 8192 + tq) * 2;
        sm[0] = w0; sm[1] = w1;
      }
      __syncthreads();
    }
  }
}

__device__ __forceinline__ void phase_attn0(const Params& p, unsigned char* smem) {
  unsigned char* ws = p.ws;
  const int tid = TIDX, lane = tid & 63, wave = tid >> 6, l31 = lane & 31, hh = lane >> 5;
  float* lut = (float*)(smem + LUT_OFF);
#pragma unroll 1
  SNAKE_LOOP(it, 1024) {
    const int qt = 63 - (it >> 4), sub = it & 15;
    const int q0 = qt * 128, t = q0 + wave * 32 + l31, tmin = q0 + wave * 32;
    {
      const int b = sub >> 3, head = sub & 7, g = head >> 2, bg = b * 2 + g;
      __syncthreads();
      build_lut(p, lut, head);
      __syncthreads();
      bf16x8 qf[8];
      load_q((const bf16_t*)(ws + O_QN) + ((size_t)(b * 8 + head) * 8192 + t) * 128, hh, qf);
      const float* gt = (const float*)(ws + O_GATES) + (size_t)(b * 8192 + t) * 24 + head * 3;
      float* oc = (float*)(ws + O_OC) + (size_t)(b * 8192 + t) * 1024 + head * 128;
      const float scale = 0.08838834764831845f;
      f32x16 o[4]; float m_run, l_run;
      {
        int lo = q0 - 511; if (lo < 0) lo = 0;
        flash_loop<128, 1>((const bf16_t*)(ws + O_KWIN) + (size_t)bg * 8192 * 128, (const bf16_t*)(ws + O_VWINT) + (size_t)bg * 128 * 8192, 8192,
                           lo >> 6, (q0 >> 6) + 2, qf, nullptr, t, tmin, scale, lut, 0, 0, nullptr, smem, o, m_run, l_run);
        const float gw = gt[2] * (l_run > 0.f ? 1.f / l_run : 0.f);
#pragma unroll
        for (int dt = 0; dt < 4; ++dt)
#pragma unroll
          for (int rq = 0; rq < 4; ++rq) {
            float4* pp = (float4*)(oc + dt * 32 + 8 * rq + 4 * hh);
            float4 v = *pp;
            v.x += o[dt][rq * 4] * gw; v.y += o[dt][rq * 4 + 1] * gw; v.z += o[dt][rq * 4 + 2] * gw; v.w += o[dt][rq * 4 + 3] * gw;
            *pp = v;
          }
      }
    }
  }
#pragma unroll 1
  SNAKE_LOOP(it, 1024) {
    const int qt = 63 - (it >> 4), sub = it & 15;
    const int q0 = qt * 128, t = q0 + wave * 32 + l31, tmin = q0 + wave * 32;
    {
      const int b = sub >> 3, head = sub & 7, g = head >> 2, bg = b * 2 + g;
      __syncthreads();
      build_lut(p, lut, head);
      __syncthreads();
      bf16x8 qf[8];
      load_q((const bf16_t*)(ws + O_QN) + ((size_t)(b * 8 + head) * 8192 + t) * 128, hh, qf);
      const float* gt = (const float*)(ws + O_GATES) + (size_t)(b * 8192 + t) * 24 + head * 3;
      const float* oc = (const float*)(ws + O_OC) + (size_t)(b * 8192 + t) * 1024 + head * 128;
      const float scale = 0.08838834764831845f;
      f32x16 o[4]; float m_run, l_run;
      {
        const u64* sm = (const u64*)(ws + O_SELM) + ((size_t)bg * 8192 + t) * 2;
        const u64 s0 = sm[0], s1 = sm[1];
        flash_loop<128, 2>((const bf16_t*)(ws + O_KSLC) + (size_t)bg * 8192 * 128, (const bf16_t*)(ws + O_VSLCT) + (size_t)bg * 128 * 8192, 8192,
                           0, (q0 >> 6) + 2, qf, nullptr, t, tmin, scale, lut, s0, s1, nullptr, smem, o, m_run, l_run);
        const float gs = gt[1] * (l_run > 0.f ? 1.f / l_run : 0.f);
        bf16_t* at = (bf16_t*)(ws + O_ATT0) + (size_t)(b * 8192 + t) * 2048 + head * 128;
#pragma unroll
        for (int dt = 0; dt < 4; ++dt)
#pragma unroll
          for (int rq = 0; rq < 4; ++rq) {
            float4 v = *(const float4*)(oc + dt * 32 + 8 * rq + 4 * hh);
            v.x += o[dt][rq * 4] * gs; v.y += o[dt][rq * 4 + 1] * gs; v.z += o[dt][rq * 4 + 2] * gs; v.w += o[dt][rq * 4 + 3] * gs;
            *(uint2*)(at + dt * 32 + 8 * rq + 4 * hh) = make_uint2(pack2(v.x, v.y), pack2(v.z, v.w));
          }
      }
    }
  }
#pragma unroll 1
  SNAKE_LOOP(it, 1024) {
    const int qt = 63 - (it >> 4), sub = it & 15;
    const int q0 = qt * 128, t = q0 + wave * 32 + l31, tmin = q0 + wave * 32;
    {
      const int s2 = sub, b = s2 >> 3, head = s2 & 7;
      bf16x8 qf[8];
      load_q((const bf16_t*)(ws + O_QMLA) + ((size_t)(b * 8 + head) * 8192 + t) * 192, hh, qf);
      bf16_t* Qsb = (bf16_t*)(smem + LUT_OFF);
      __syncthreads();
#pragma unroll
      for (int i = 0; i < 4; ++i) {
        int c = tid + i * 256, row = c >> 3, cc = c & 7;
        *(u32x4*)(Qsb + row * 72 + cc * 8) = *(const u32x4*)((const bf16_t*)(ws + O_QMLA) + ((size_t)(b * 8 + head) * 8192 + q0 + row) * 192 + 128 + cc * 8);
      }
      const bf16_t* Qs = Qsb + (wave * 32 + l31) * 72;
      f32x16 o[4]; float m_run, l_run;
      flash_loop<192, 0>((const bf16_t*)(ws + O_KMLA) + (size_t)(b * 8 + head) * 8192 * 192, (const bf16_t*)(ws + O_VMLAT) + (size_t)(b * 8 + head) * 128 * 8192, 8192,
                         0, (q0 >> 6) + 2, qf, Qs, t, tmin, 0.07216878364870322f, nullptr, 0, 0, nullptr, smem, o, m_run, l_run);
      const float il = l_run > 0.f ? 1.f / l_run : 0.f;
      bf16_t* at = (bf16_t*)(ws + O_ATT0) + (size_t)(b * 8192 + t) * 2048 + 1024 + head * 128;
#pragma unroll
      for (int dt = 0; dt < 4; ++dt)
#pragma unroll
        for (int rq = 0; rq < 4; ++rq)
          *(uint2*)(at + dt * 32 + 8 * rq + 4 * hh) = make_uint2(pack2(o[dt][rq * 4] * il, o[dt][rq * 4 + 1] * il), pack2(o[dt][rq * 4 + 2] * il, o[dt][rq * 4 + 3] * il));
    }
  }
}

__device__ __forceinline__ unsigned okey(float f) {
  unsigned u = __float_as_uint(f);
  return (u & 0x80000000u) ? ~u : (u | 0x80000000u);
}

__device__ __forceinline__ void phase_indexer(const Params& p, unsigned char* smem) {
  unsigned char* ws = p.ws;
  const int tid = TIDX, lane = tid & 63, wave = tid >> 6, l31 = lane & 31, hh = lane >> 5;
  _Float16* IQs = (_Float16*)smem;
  const _Float16* IQ = (const _Float16*)(ws + O_IQ);
  const _Float16* IK = (const _Float16*)(ws + O_IK);
  const float* IW = (const float*)(ws + O_IW);
  SNAKE_LOOP(it, 1024) {
    const int qt = 255 - (it >> 2), b = (it >> 1) & 1, kh = it & 1;
    const int q0 = qt * 32;
    float* scb = (float*)(ws + O_SC) + (size_t)b * SC_PERB + 1024ull * ((size_t)qt * (qt + 1) / 2);
    const int stride = 32 * (qt + 1);
    __syncthreads();
#pragma unroll
    for (int i = 0; i < 16; ++i) {
      int c = tid + i * 256, q = c >> 7, cc = c & 127;
      *(u32x4*)(IQs + q * 1032 + cc * 8) = *(const u32x4*)(IQ + ((size_t)(b * 8192 + q0 + q) * 1024 + cc * 8));
    }
    float* IWs = (float*)(smem + 66048);
    for (int e = tid; e < 512; e += 256) IWs[e] = IW[(size_t)(b * 8192 + q0) * 16 + e];
    __syncthreads();
    const int npairs = (qt + 2) >> 1;
    for (int pi = 2 * wave + kh; pi < npairs; pi += 8) {
      const int kb0 = 2 * pi, kb1 = 2 * pi + 1;
      f16x8 a0[4], a1[4];
#pragma unroll
      for (int ks = 0; ks < 4; ++ks) {
        a0[ks] = *(const f16x8*)(IK + ((size_t)(b * 8192 + kb0 * 32 + l31) * 64 + ks * 16 + hh * 8));
        a1[ks] = *(const f16x8*)(IK + ((size_t)(b * 8192 + kb1 * 32 + l31) * 64 + ks * 16 + hh * 8));
      }
      f32x16 tot0, tot1;
#pragma unroll
      for (int r = 0; r < 16; ++r) { tot0[r] = 0.f; tot1[r] = 0.f; }
#pragma unroll 1
      for (int hd = 0; hd < 16; ++hd) {
        f32x16 s0, s1;
#pragma unroll
        for (int r = 0; r < 16; ++r) { s0[r] = 0.f; s1[r] = 0.f; }
#pragma unroll
        for (int ks = 0; ks < 4; ++ks) {
          f16x8 bq = *(const f16x8*)(IQs + l31 * 1032 + hd * 64 + ks * 16 + hh * 8);
          s0 = MFMA_F16(a0[ks], bq, s0);
          s1 = MFMA_F16(a1[ks], bq, s1);
        }
        const float w = IWs[l31 * 16 + hd];
#pragma unroll
        for (int r = 0; r < 16; ++r) { tot0[r] += w * fmaxf(s0[r], 0.f); tot1[r] += w * fmaxf(s1[r], 0.f); }
      }
      float* rowp = scb + (size_t)l31 * stride;
#pragma unroll
      for (int rq = 0; rq < 4; ++rq) {
        *(float4*)(rowp + kb0 * 32 + 8 * rq + 4 * hh) = make_float4(tot0[rq * 4] + 0.f, tot0[rq * 4 + 1] + 0.f, tot0[rq * 4 + 2] + 0.f, tot0[rq * 4 + 3] + 0.f);
      }
      if (kb1 <= qt) {
#pragma unroll
        for (int rq = 0; rq < 4; ++rq) {
          *(float4*)(rowp + kb1 * 32 + 8 * rq + 4 * hh) = make_float4(tot1[rq * 4] + 0.f, tot1[rq * 4 + 1] + 0.f, tot1[rq * 4 + 2] + 0.f, tot1[rq * 4 + 3] + 0.f);
        }
      }
    }
  }
}

__device__ __forceinline__ void phase_select(const Params& p, unsigned char* smem) {
  unsigned char* ws = p.ws;
  const int tid = TIDX, lane = tid & 63, wave = tid >> 6;
  unsigned* hist = (unsigned*)smem + wave * 2112;
  unsigned* kl = (unsigned*)(smem + 36864) + wave * 1024 + lane;
#define KEY(w) ((w) < 16 ? kl[(w) * 64] : key[(w) - 16])
#pragma unroll 1
  SNAKE_LOOP(idx4, 4096) {
    const int idx = idx4 * 4 + wave;
    const int t = 8191 - (idx >> 1), b = idx & 1;
    const int qt = t >> 5, q = t & 31;
    const float* rowp = (const float*)(ws + O_SC) + (size_t)b * SC_PERB + 1024ull * ((size_t)qt * (qt + 1) / 2) + (size_t)q * (32 * (qt + 1));
    unsigned key[112];
#pragma unroll
    for (int w = 0; w < 128; ++w) {
      const int s = w * 64 + lane;
      const int scl = min(s, t);
      const unsigned kk = okey(rowp[scl]);
      const unsigned vm = 0u - (unsigned)min(max(t + 1 - s, 0), 1);
      if (w < 16) kl[w * 64] = kk & vm; else key[w - 16] = kk & vm;
    }
    asm volatile("s_waitcnt lgkmcnt(0)" ::: "memory");
    unsigned T = 0; int need = 0, eqc = 0;
    if (t + 1 > 256) {
      unsigned prefix = 0; int krem = 256;
#pragma unroll 1
      for (int pass = 0; pass < 3; ++pass) {
        const int shift = pass == 0 ? 21 : (pass == 1 ? 10 : 0);
        const int nbits = pass == 2 ? 10 : 11;
        const unsigned dmask = (1u << nbits) - 1u;
        unsigned klo = 1u, khi = 0xFFFFFFFFu;
        if (pass > 0) { klo = prefix << (shift + nbits); khi = klo | ((1u << (shift + nbits)) - 1u); if (klo == 0u) klo = 1u; }
        const unsigned span = khi - klo;
#pragma unroll
        for (int e = 0; e < 32; ++e) hist[e * 64 + lane] = 0;
        asm volatile("s_waitcnt lgkmcnt(0)" ::: "memory");
#pragma unroll
        for (int w = 0; w < 128; ++w) {
          const unsigned k = KEY(w);
          const unsigned d = k - klo;
          const unsigned nz = min(d - min(d, span), 1u);
          const unsigned fk = (k >> shift) & dmask;
          const unsigned bin = fk + nz * (2048u + (unsigned)lane - fk);
          atomicAdd(&hist[bin], 1u);
        }
        asm volatile("s_waitcnt lgkmcnt(0)" ::: "memory");
        unsigned local = 0;
#pragma unroll
        for (int j = 0; j < 32; ++j) local += hist[lane * 32 + j];
        unsigned incl = local;
#pragma unroll
        for (int o = 1; o < 64; o <<= 1) { unsigned v = __shfl_down(incl, o); if (lane + o < 64) incl += v; }
        const unsigned above = incl - local;
        const bool mine = ((int)above < krem) && ((int)(above + local) >= krem);
        unsigned dig = 0, kr = 0, hc = 0;
        if (mine) {
          unsigned acc = above; bool done = false;
#pragma unroll 1
          for (int j = 31; j >= 0; --j) {
            const unsigned h = hist[lane * 32 + j];
            if (!done && (int)(acc + h) >= krem) { dig = (unsigned)(lane * 32 + j); kr = (unsigned)(krem - (int)acc); hc = h; done = true; }
            acc += h;
          }
        }
        const int src = __ffsll((unsigned long long)__ballot(mine)) - 1;
        dig = (unsigned)__shfl((int)dig, src); kr = (unsigned)__shfl((int)kr, src); hc = (unsigned)__shfl((int)hc, src);
        prefix = (prefix << nbits) | dig;
        krem = (int)kr; eqc = (int)hc;
        asm volatile("s_waitcnt lgkmcnt(0)" ::: "memory");
      }
      T = prefix; need = krem;
    }
    u64* bm = (u64*)(ws + O_BITM) + (size_t)(b * 8192 + t) * 128;
    if (need == eqc) {
      unsigned v0lo = 0, v0hi = 0, v1lo = 0, v1hi = 0;
#pragma unroll
      for (int w = 0; w < 128; ++w) {
        const unsigned kw = KEY(w);
        const u64 word = __ballot(kw >= T && kw != 0u);
        const unsigned wl = (unsigned)word, wh = (unsigned)(word >> 32);
        if (w < 64) {
          asm volatile("s_nop 1\n\tv_writelane_b32 %0, %1, %2" : "+v"(v0lo) : "s"(wl), "n"(w & 63));
          asm volatile("v_writelane_b32 %0, %1, %2" : "+v"(v0hi) : "s"(wh), "n"(w & 63));
        } else {
          asm volatile("s_nop 1\n\tv_writelane_b32 %0, %1, %2" : "+v"(v1lo) : "s"(wl), "n"(w & 63));
          asm volatile("v_writelane_b32 %0, %1, %2" : "+v"(v1hi) : "s"(wh), "n"(w & 63));
        }
      }
      bm[lane] = ((u64)v0hi << 32) | v0lo; bm[64 + lane] = ((u64)v1hi << 32) | v1lo;
    } else {
      int base = 0;
#pragma unroll 1
      for (int w = 0; w < 128; ++w) {
        const int s = w * 64 + lane;
        unsigned k = 0;
        if (s <= t) k = okey(rowp[s]);
        const bool gt = (s <= t) && k > T;
        const bool eq = (s <= t) && k == T;
        const u64 eqm = __ballot(eq);
        const int rank = base + (int)__builtin_amdgcn_mbcnt_hi((unsigned)(eqm >> 32), __builtin_amdgcn_mbcnt_lo((unsigned)eqm, 0u));
        const u64 word = __ballot(gt || (eq && rank < need));
        base += __popcll(eqm);
        if (lane == 0) bm[w] = word;
      }
    }
  }
}

#undef KEY
__device__ __forceinline__ void phase_dsa_attn(const Params& p, unsigned char* smem) {
  unsigned char* ws = p.ws;
  const int tid = TIDX, lane = tid & 63, wave = tid >> 6, l31 = lane & 31, hh = lane >> 5;
  float* lut = (float*)(smem + LUT_OFF);
  SNAKE_LOOP(it, 2048) {
    const int qt = 63 - (it >> 5), sub = it & 31, b = sub >> 4, head = sub & 15, kvh = head >> 2;
    const int q0 = qt * 128, t = q0 + wave * 32 + l31, tmin = q0 + wave * 32;
    __syncthreads();
    build_lut(p, lut, head);
    __syncthreads();
    bf16x8 qf[8];
    load_q((const bf16_t*)(ws + O_QD) + ((size_t)(b * 16 + head) * 8192 + t) * 128, hh, qf);
    f32x16 o[4]; float m_run, l_run;
    flash_loop<128, 3>((const bf16_t*)(ws + O_KD) + (size_t)(b * 4 + kvh) * 8192 * 128, (const bf16_t*)(ws + O_VDT) + (size_t)(b * 4 + kvh) * 128 * 8192, 8192,
                       0, (q0 >> 6) + 2, qf, nullptr, t, tmin, 0.08838834764831845f, lut, 0, 0, (const u64*)(ws + O_BITM) + (size_t)(b * 8192 + t) * 128, smem, o, m_run, l_run);
    const float il = l_run > 0.f ? 1.f / l_run : 0.f;
    bf16_t* at = (bf16_t*)(ws + O_ATT1) + (size_t)(b * 8192 + t) * 2048 + head * 128;
#pragma unroll
    for (int dt = 0; dt < 4; ++dt)
#pragma unroll
      for (int rq = 0; rq < 4; ++rq)
        *(uint2*)(at + dt * 32 + 8 * rq + 4 * hh) = make_uint2(pack2(o[dt][rq * 4] * il, o[dt][rq * 4 + 1] * il), pack2(o[dt][rq * 4 + 2] * il, o[dt][rq * 4 + 3] * il));
  }
}

#define XB_TMO      128
#define XB_XCNT(j)  (256  + 64 * (j))
#define XB_XSUB(j)  (1280 + 64 * (j))
#define XB_XGEN(j)  (2304 + 64 * (j))
#define XB_TOP      3328
#define XB_TOPGEN   3392
#define XCD_BAR_WORDS 3456
#define XB_SPIN_CAP (1u << 25)
#define LAS __attribute__((address_space(3)))

__device__ __forceinline__ unsigned xb_ld(unsigned* p)              { return __hip_atomic_load(p, __ATOMIC_RELAXED, __HIP_MEMORY_SCOPE_AGENT); }
__device__ __forceinline__ unsigned xb_add(unsigned* p, unsigned v) { return __hip_atomic_fetch_add(p, v, __ATOMIC_RELAXED, __HIP_MEMORY_SCOPE_AGENT); }
__device__ __forceinline__ unsigned xb_xcc_id() { return (unsigned)__builtin_amdgcn_s_getreg((3 << 11) | 20) & 0xFu; }
#define XB_SPIN(cond, bar) do { unsigned _sp = 0; while (cond) { __builtin_amdgcn_s_sleep(1); \
    if ((++_sp & 255u) == 0u) { if (xb_ld(&(bar)[XB_TMO])) break; if (_sp > XB_SPIN_CAP) { atomicAdd(&(bar)[XB_TMO], 1u); break; } } } } while (0)

struct XcdBarrier {
    unsigned* bar; unsigned x;
    volatile LAS unsigned* st;
};

__device__ __forceinline__ XcdBarrier xcd_barrier_post(unsigned* bar, volatile LAS unsigned* st) {
    XcdBarrier b; b.bar = bar; b.x = xb_xcc_id(); b.st = st;
    if (TIDX == 0) (void)xb_add(&bar[XB_XCNT(b.x)], 1u);
    return b;
}
__device__ __forceinline__ void xcd_barrier_complete(unsigned* bar, unsigned x, unsigned& nloc, unsigned& nx) {
    const unsigned G = gridDim.x * gridDim.y * gridDim.z;
    unsigned sum, cnt, mine, sp = 0u;
    for (;;) {
        sum = 0u; cnt = 0u; mine = 0u;
#pragma unroll
        for (unsigned j = 0; j < 16; ++j) { const unsigned c = xb_ld(&bar[XB_XCNT(j)]); sum += c; cnt += (c > 0u) ? 1u : 0u; mine = (j == x) ? c : mine; }
        if (sum == G) break;
        __builtin_amdgcn_s_sleep(1);
        if ((++sp & 255u) == 0u) { if (xb_ld(&bar[XB_TMO])) break; if (sp > XB_SPIN_CAP) { atomicAdd(&bar[XB_TMO], 1u); break; } }
    }
    nloc = mine > 0u ? mine : 1u; nx = cnt > 0u ? cnt : 1u;
}

__device__ __forceinline__ void xcd_barrier(const XcdBarrier& b) {
    asm volatile("s_waitcnt vmcnt(0)" ::: "memory");
    __syncthreads();
    if (TIDX == 0) {
        unsigned* bar = b.bar;
        const unsigned bx = xb_xcc_id();
        __builtin_amdgcn_s_waitcnt(0);
        unsigned nloc = b.st[0], nx = b.st[1];
        if (nloc == 0u) { xcd_barrier_complete(bar, bx, nloc, nx); b.st[0] = nloc; b.st[1] = nx; }
        const unsigned old = xb_add(&bar[XB_XSUB(bx)], 1u);
        const unsigned gen = old / nloc;
        if (old + 1u == (gen + 1u) * nloc) {
            __builtin_amdgcn_fence(__ATOMIC_RELEASE, "agent");
            asm volatile("s_waitcnt vmcnt(0)" ::: "memory");
            const unsigned og = xb_add(&bar[XB_TOP], 1u);
            const unsigned tg = og / nx;
            if (og + 1u == (tg + 1u) * nx) xb_add(&bar[XB_TOPGEN], 1u);
            else XB_SPIN(xb_ld(&bar[XB_TOPGEN]) == tg, bar);
            __builtin_amdgcn_fence(__ATOMIC_ACQUIRE, "agent");
            xb_add(&bar[XB_XGEN(bx)], 1u);
            asm volatile("s_waitcnt vmcnt(0)" ::: "memory");
        } else {
            XB_SPIN(xb_ld(&bar[XB_XGEN(bx)]) == gen, bar);
            __builtin_amdgcn_fence(__ATOMIC_ACQUIRE, "agent");
            asm volatile("s_waitcnt vmcnt(0)" ::: "memory");
        }
    }
    __syncthreads();
}


#define NPHASES 20
#ifndef ONLY_PHASE
#define ONLY_PHASE -1
#endif
#define PH(n) (ONLY_PHASE < 0 || ONLY_PHASE == (n))
typedef const Params __attribute__((address_space(4))) * KParamsP;
__device__ __forceinline__ void get_params(Params& lp) {
  KParamsP pp = (KParamsP)__builtin_amdgcn_kernarg_segment_ptr();
  asm volatile("" : "+s"(pp));
#pragma unroll
  for (int i = 0; i < 27; ++i) lp.in[i] = pp->in[i];
  lp.out = pp->out; lp.ws = pp->ws; lp.ph_lo = 0; lp.ph_hi = 0;
}
#ifndef REPEAT_MASK
#define REPEAT_MASK 0
#endif
#define RUNPH(n, call) if (PH(n)) { Params p; get_params(p); unsigned char* ws = p.ws; (void)ws; call; if ((REPEAT_MASK >> (n)) & 1) { grid.sync(); call; } }

__global__ void __launch_bounds__(256, 2) mega(Params p_unused) {
  __shared__ __attribute__((aligned(16))) unsigned char smem[SMEM_BYTES];
  cg::grid_group grid = cg::this_grid();
  __shared__ uint4 xb_words;
  if (TIDX == 0) xb_words = make_uint4(0u, 0u, 0u, 0u);
  __syncthreads();
  XcdBarrier xb;
  { Params p; get_params(p); xb = xcd_barrier_post((unsigned*)(p.ws + O_BAR), (volatile LAS unsigned*)&xb_words); }
  RUNPH(0, phase_prep(p, smem))
  grid.sync();
  RUNPH(1, phase_reduce(p))
  xcd_barrier(xb);
#pragma unroll 1
  for (int L = 0; L < 2; ++L) {
    RUNPH(2, phase_norm(p, L == 0 ? p.in[I_X] : p.out, 2 * L))
    xcd_barrier(xb);
    if (L == 0) {
      RUNPH(3, phase_evin(p, smem))
      xcd_barrier(xb);
      RUNPH(4, phase_mid(p, smem))
      xcd_barrier(xb);
      RUNPH(5, phase_cmp2(p, smem))
      xcd_barrier(xb);
      RUNPH(6, phase_cmp_attn(p, smem))
      xcd_barrier(xb);
      RUNPH(7, phase_attn0(p, smem))
      xcd_barrier(xb);
    } else {
      RUNPH(13, phase_odin(p, smem))
      xcd_barrier(xb);
      RUNPH(14, phase_indexer(p, smem))
      xcd_barrier(xb);
      RUNPH(16, phase_select(p, smem))
      xcd_barrier(xb);
      RUNPH(15, phase_dsa_attn(p, smem))
      xcd_barrier(xb);
    }
    RUNPH(8, phase_resid(p, (const bf16_t*)(ws + (L == 0 ? O_ATT0 : O_ATT1)), 2048, (const bf16_t*)(ws + (L == 0 ? O_WEVOUT : O_WODOUT)),
                         L == 0 ? p.in[I_X] : p.out, p.out, 2 * L, smem))
    xcd_barrier(xb);
    RUNPH(2, phase_norm(p, p.out, 2 * L + 1))
    xcd_barrier(xb);
    RUNPH(10, phase_ffn_up(p, L, smem))
    xcd_barrier(xb);
    RUNPH(8, phase_resid(p, (const bf16_t*)(ws + O_ACT), 4096, (const bf16_t*)(ws + O_WDOWN) + (size_t)L * 2048 * 4096, p.out, p.out, 2 * L + 1, smem))
    if (L == 0) xcd_barrier(xb);
  }
}

extern "C" void kernel_launch(void* const* d_in, const int* in_sizes, int n_in, void* d_out, int out_size, void* d_ws, size_t ws_size,
                              hipStream_t stream) {
  static int grid_blocks = 0;
  if (!grid_blocks) {
    int dev = 0, cus = 0, per_cu = 0;
    hipGetDevice(&dev);
    hipDeviceGetAttribute(&cus, hipDeviceAttributeMultiprocessorCount, dev);
    hipOccupancyMaxActiveBlocksPerMultiprocessor(&per_cu, mega, 256, 0);
    if (per_cu < 1) per_cu = 1;
    if (per_cu > 2) per_cu = 2;
    grid_blocks = cus * per_cu;
    if (n_in != 27 || ws_size < WS_NEED) {
      fprintf(stderr, "kernel_launch: need %zu bytes of workspace, got %zu (n_in %d)\n", (size_t)WS_NEED, ws_size, n_in);
      grid_blocks = -1;
    }
  }
  if (grid_blocks < 0) return;
  (void)hipMemsetAsync((unsigned char*)d_ws + O_BAR, 0, XCD_BAR_WORDS * sizeof(unsigned), stream);
  Params p{};
  for (int i = 0; i < 27; ++i) p.in[i] = (const float*)d_in[i];
  p.out = (float*)d_out;
  p.ws = (unsigned char*)d_ws;
  p.ph_lo = 0; p.ph_hi = NPHASES;
  void* args[] = {&p};
  hipError_t e = hipLaunchCooperativeKernel((void*)mega, dim3(grid_blocks), dim3(256), args, 0, stream);
  if (e != hipSuccess) fprintf(stderr, "cooperative launch failed: %s (grid %d)\n", hipGetErrorString(e), grid_blocks);
}
```
